# Optimizing an MI355X kernel written in HIP

```python
import jax, jax.numpy as jnp
from jax import lax
import numpy as np

D_MODEL = 1024
BATCH = 1
SEQ = 16384
DEPTH = 4
DEC_BATCH = 16
DEC_SEQ = 4096
PAST_LEN = 128

RET_HEADS = 8
RET_DK = 64
RET_DV = 128
D_QK = RET_HEADS * RET_DK
D_V = RET_HEADS * RET_DV
CHUNK = 128
ROPE_BASE = 10000.0
POOL_WINDOWS = (2, 4, 8, 16)
POOL_GROUPS = 4
D_POOL = D_MODEL
POOL_GW = D_POOL // POOL_GROUPS
D_FF = 4 * D_MODEL
EPS = 1e-6
IN_SPLITS = (D_QK, D_QK, D_V, D_V, D_POOL, D_MODEL, D_MODEL)
D_IN = D_QK + D_QK + D_V + D_V + D_POOL + D_MODEL + D_MODEL

kernel_name = "hybrid_retention_pool_encoder"


def rms_norm(x, g):
    xf = x.astype(jnp.float32)
    y = xf * lax.rsqrt(jnp.mean(xf * xf, axis=-1, keepdims=True) + EPS)
    return (y * g.astype(jnp.float32)).astype(x.dtype)


def rope(x):
    s, d = x.shape[1], x.shape[-1]
    half = d // 2
    inv = ROPE_BASE ** (-jnp.arange(half, dtype=jnp.float32) / half)
    ang = jnp.arange(s, dtype=jnp.float32)[:, None] * inv[None, :]
    cos = jnp.cos(ang)[None, :, None, :]
    sin = jnp.sin(ang)[None, :, None, :]
    xf = x.astype(jnp.float32)
    x1, x2 = xf[..., :half], xf[..., half:]
    return jnp.concatenate([x1 * cos - x2 * sin, x1 * sin + x2 * cos], axis=-1)


def retention_scan(q, k, v, log_g, strict):
    b, s, h, dk = q.shape
    dv = v.shape[-1]
    n = s // CHUNK
    qc = q.reshape(b, n, CHUNK, h, dk)
    kc = k.reshape(b, n, CHUNK, h, dk)
    vc = v.reshape(b, n, CHUNK, h, dv)
    idx = jnp.arange(CHUNK, dtype=jnp.float32)
    diff = idx[:, None] - idx[None, :]
    mask = diff > 0 if strict else diff >= 0
    safe = jnp.where(mask, diff, 0.0)
    decay = jnp.where(mask[None], jnp.exp(safe[None] * log_g[:, None, None]), 0.0)
    scores = jnp.einsum('bnihd,bnjhd->bnhij', qc, kc) * decay[None, None]
    intra = jnp.einsum('bnhij,bnjhe->bnihe', scores, vc)
    zeta = jnp.exp((CHUNK - 1.0 - idx)[None, :] * log_g[:, None])
    xi = jnp.exp((idx + 1.0)[None, :] * log_g[:, None])
    chunk_decay = jnp.exp(CHUNK * log_g)[None, :, None, None]
    kv = jnp.einsum('bnjhd,hj,bnjhe->nbhde', kc, zeta, vc)

    def step(state, kv_n):
        return chunk_decay * state + kv_n, state

    _, prev_states = lax.scan(step, jnp.zeros((b, h, dk, dv), jnp.float32), kv)
    inter = jnp.einsum('bnihd,hi,nbhde->bnihe', qc, xi, prev_states)
    return (intra + inter).reshape(b, s, h, dv)


def retention_branch(q, k, v, g, decay_fwd, decay_bwd, gn_gain):
    b, s, _ = q.shape
    qh = rope(q.reshape(b, s, RET_HEADS, RET_DK))
    kh = rope(k.reshape(b, s, RET_HEADS, RET_DK)) * (RET_DK ** -0.5)
    vh = v.reshape(b, s, RET_HEADS, RET_DV).astype(jnp.float32)
    lg_f = jax.nn.log_sigmoid(decay_fwd.astype(jnp.float32))
    lg_b = jax.nn.log_sigmoid(decay_bwd.astype(jnp.float32))
    o_f = retention_scan(qh, kh, vh, lg_f, strict=False)
    o_b = jnp.flip(retention_scan(jnp.flip(qh, 1), jnp.flip(kh, 1), jnp.flip(vh, 1), lg_b, strict=True), 1)
    o = o_f + o_b
    mu = jnp.mean(o, axis=-1, keepdims=True)
    var = jnp.mean(jnp.square(o - mu), axis=-1, keepdims=True)
    o = (o - mu) * lax.rsqrt(var + EPS) * gn_gain.astype(jnp.float32).reshape(RET_HEADS, RET_DV)
    y = jax.nn.silu(g.astype(jnp.float32)) * o.reshape(b, s, D_V)
    return y.astype(g.dtype)


def pool_branch(u, w_pool, scale):
    b, s, _ = u.shape
    uf = u.astype(jnp.float32).reshape(b, s, POOL_GROUPS, POOL_GW)
    cs = jnp.concatenate([jnp.zeros((b, 1, POOL_GROUPS, POOL_GW), jnp.float32), jnp.cumsum(uf, axis=1)], axis=1)
    pos = jnp.arange(s)
    outs = []
    for gi, w in enumerate(POOL_WINDOWS):
        half = w // 2
        hi = jnp.minimum(pos + half, s)
        lo = jnp.maximum(pos - half, 0)
        csg = cs[:, :, gi]
        seg = jnp.take(csg, hi, axis=1) - jnp.take(csg, lo, axis=1)
        mean = seg / (hi - lo).astype(jnp.float32)[None, :, None]
        outs.append(mean - uf[:, :, gi])
    p = jnp.stack(outs, axis=2)
    y = jnp.einsum('bsgc,gcd->bsgd', p, w_pool.astype(jnp.float32)).reshape(b, s, D_POOL)
    return (y * scale.astype(jnp.float32)).astype(u.dtype)


def trunk(x, norm_mix_pre, norm_mix_post, w_in, ret_decay_fwd, ret_decay_bwd, ret_gn,
          pool_w, pool_scale, w_out, norm_mlp_pre, norm_mlp_post, w_mlp1, w_mlp2):
    cuts = [int(c) for c in np.cumsum(IN_SPLITS)[:-1]]
    for l in range(DEPTH):
        h = rms_norm(x, norm_mix_pre[l])
        proj = jnp.einsum('bsd,de->bse', h, w_in[l])
        q, k, v, g, u, gr, gp = jnp.split(proj, cuts, axis=-1)
        y_r = retention_branch(q, k, v, g, ret_decay_fwd[l], ret_decay_bwd[l], ret_gn[l])
        y_p = pool_branch(u, pool_w[l], pool_scale[l])
        m = jax.nn.sigmoid(gr) * y_r + jax.nn.sigmoid(gp) * y_p
        x = x + rms_norm(jnp.einsum('bsd,de->bse', m, w_out[l]), norm_mix_post[l])
        h2 = rms_norm(x, norm_mlp_pre[l])
        f = jnp.square(jax.nn.relu(jnp.einsum('bsd,df->bsf', h2, w_mlp1[l])))
        f = jnp.einsum('bsf,fd->bsd', f, w_mlp2[l])
        x = x + rms_norm(f, norm_mlp_post[l])
    return x


def setup_inputs(seed: int = 0) -> dict:
    key = jax.random.key(seed)
    ks = jax.random.split(key, 16)
    f32 = jnp.float32
    base_decay = jnp.log(2.0 ** (5.0 + jnp.arange(RET_HEADS, dtype=f32)) - 1.0)
    return {
        "x_prompt": jax.random.normal(ks[0], (BATCH, SEQ, D_MODEL), f32),
        "x_sample": jax.random.normal(ks[1], (DEC_BATCH, DEC_SEQ, D_MODEL), f32),
        "norm_mix_pre": 1.0 + 0.05 * jax.random.normal(ks[2], (DEPTH, D_MODEL), f32),
        "norm_mix_post": 1.0 + 0.05 * jax.random.normal(ks[3], (DEPTH, D_MODEL), f32),
        "w_in": jax.random.normal(ks[4], (DEPTH, D_MODEL, D_IN), f32) * D_MODEL ** -0.5,
        "ret_decay_fwd": base_decay[None, :] + 0.1 * jax.random.normal(ks[5], (DEPTH, RET_HEADS), f32),
        "ret_decay_bwd": base_decay[None, :] + 0.1 * jax.random.normal(ks[6], (DEPTH, RET_HEADS), f32),
        "ret_gn": 1.0 + 0.05 * jax.random.normal(ks[7], (DEPTH, D_V), f32),
        "pool_w": jax.random.normal(ks[8], (DEPTH, POOL_GROUPS, POOL_GW, POOL_GW), f32) * POOL_GW ** -0.5,
        "pool_scale": 1.0 + 0.05 * jax.random.normal(ks[9], (DEPTH, D_POOL), f32),
        "w_out": jax.random.normal(ks[10], (DEPTH, D_MODEL, D_MODEL), f32) * D_MODEL ** -0.5,
        "norm_mlp_pre": 1.0 + 0.05 * jax.random.normal(ks[11], (DEPTH, D_MODEL), f32),
        "norm_mlp_post": 1.0 + 0.05 * jax.random.normal(ks[12], (DEPTH, D_MODEL), f32),
        "w_mlp1": jax.random.normal(ks[13], (DEPTH, D_MODEL, D_FF), f32) * D_MODEL ** -0.5,
        "w_mlp2": jax.random.normal(ks[14], (DEPTH, D_FF, D_MODEL), f32) * D_FF ** -0.5,
    }


def reference(x_prompt, x_sample, norm_mix_pre, norm_mix_post, w_in, ret_decay_fwd, ret_decay_bwd,
              ret_gn, pool_w, pool_scale, w_out, norm_mlp_pre, norm_mlp_post, w_mlp1, w_mlp2):
    y_prompt = trunk(x_prompt, norm_mix_pre, norm_mix_post, w_in, ret_decay_fwd, ret_decay_bwd, ret_gn,
                     pool_w, pool_scale, w_out, norm_mlp_pre, norm_mlp_post, w_mlp1, w_mlp2)
    y_sample = trunk(x_sample, norm_mix_pre, norm_mix_post, w_in, ret_decay_fwd, ret_decay_bwd, ret_gn,
                     pool_w, pool_scale, w_out, norm_mlp_pre, norm_mlp_post, w_mlp1, w_mlp2)
    return (y_prompt, y_sample)
```

```cpp
#include <hip/hip_runtime.h>
#include <hip/hip_cooperative_groups.h>
#include <cstdio>
#include <cstdint>
namespace cg = cooperative_groups;
namespace pg8 {
#define PG8_LAS __attribute__((address_space(3)))
typedef unsigned short bf16_t;
typedef short bf16x8 __attribute__((ext_vector_type(8)));
typedef float f32x4 __attribute__((ext_vector_type(4)));
typedef unsigned u32x4 __attribute__((ext_vector_type(4)));
constexpr int BM = 256, BK = 64, HALF = 128, HTB = HALF * BK * 2  , STAGE_BYTES = 8 * HTB, NXCD = 8, WGM = 8;

__host__ __device__ __forceinline__ int lds_byte(int r, int c) { const int st = (r >> 4) * 2 + (c >> 5), rr = r & 15, cc = c & 31, ob = rr * 64 + cc * 2; return st * 1024 + (ob ^ (((ob >> 9) & 1) << 5)); }
__host__ __device__ __forceinline__ void stage_rc(int b, int& R, int& C) { const int st = b / 1024, sb = b % 1024, swz = sb ^ (((sb >> 9) & 1) << 5); R = (st >> 1) * 16 + swz / 64; C = (st & 1) * 32 + (swz % 64) / 2; }
__host__ __device__ __forceinline__ int perm32(int rho) { const int n = rho >> 4, i = rho & 15; return 8 * (i >> 2) + 4 * n + (i & 3); }

struct Unit { int pm, pn; };
struct Gemm { const bf16_t* A; const bf16_t* Bt; int M, N, K; };

struct StaticOrder {
    int nM, nN, nwg, G, c;
    __host__ __device__ void init(int M, int N, int G_, int c_) { nM = M / BM; nN = N / BM; nwg = nM * nN; G = G_; c = c_; }
    __host__ __device__ bool next(int i, Unit& u) const {
        const long L = (long)i * G + c; if (L >= nwg) return false;
        int wgid = (int)L; { const int q = nwg / NXCD, r = nwg % NXCD, xcd = wgid % NXCD, off = wgid / NXCD; wgid = (xcd < r ? xcd * (q + 1) : r * (q + 1) + (xcd - r) * q) + off; }
        const int nig = WGM * nN, gid = wgid / nig, fm = gid * WGM, gsz = (nM - fm) < WGM ? (nM - fm) : WGM;
        u.pm = fm + ((wgid % nig) % gsz); u.pn = (wgid % nig) / gsz; return true;
    }
    __device__ __forceinline__ void a_ready(const Unit&) const {}
    __device__ __forceinline__ void done(const Unit&) const {}
};

typedef float f32x2 __attribute__((ext_vector_type(2)));
typedef __bf16 bf2_t __attribute__((ext_vector_type(2)));
__device__ __forceinline__ unsigned pk(float lo, float hi) { f32x2 v = {lo, hi}; bf2_t b = __builtin_convertvector(v, bf2_t); return __builtin_bit_cast(unsigned, b); }
__device__ __forceinline__ float sigm(float x) { return __builtin_amdgcn_rcpf(1.0f + __expf(-x)); }

template <int ACT  > struct EpiBf {
    static constexpr bool PERM = true, AFTER_DRAIN = false;
    bf16_t* O; size_t ldc;
    __device__ __forceinline__ void operator()(const f32x4 (&acc)[2][2][4][2], const Unit& u, int wr, int wc, int fr, int fq) const {
        const int row0 = u.pm * BM + wr * 64 + fr; const int col0 = u.pn * BM + wc * 32 + 8 * fq;
#pragma unroll
        for (int ai = 0; ai < 2; ++ai)
#pragma unroll
            for (int m = 0; m < 4; ++m) { bf16_t* rowp = O + (size_t)(row0 + ai * HALF + m * 16) * ldc + col0;
#pragma unroll
                for (int bj = 0; bj < 2; ++bj) { f32x4 v0 = acc[ai][bj][m][0], v1 = acc[ai][bj][m][1];
                    if (ACT == 1) {
#pragma unroll
                        for (int j = 0; j < 4; ++j) { const float a = fmaxf(v0[j], 0.f), b = fmaxf(v1[j], 0.f); v0[j] = a * a; v1[j] = b * b; } }
                    u32x4 w; w.x = pk(v0[0], v0[1]); w.y = pk(v0[2], v0[3]); w.z = pk(v1[0], v1[1]); w.w = pk(v1[2], v1[3]);
                    *(u32x4*)(rowp + bj * HALF) = w; } }
    }
};

struct EpiWin {
    static constexpr bool PERM = true, AFTER_DRAIN = false;
    bf16_t *Q, *Kb, *G1, *U, *SGP; const float* rope;
    __device__ __forceinline__ void operator()(const f32x4 (&acc)[2][2][4][2], const Unit& u, int wr, int wc, int fr, int fq) const {
        const int pn = u.pn; const int row0 = u.pm * BM + wr * 64 + fr;
        if (pn < 4) {
            bf16_t* dst = pn < 2 ? Q : Kb; const int head = (pn & 1) * 4 + wc;
#pragma unroll
            for (int ai = 0; ai < 2; ++ai)
#pragma unroll
                for (int m = 0; m < 4; ++m) {
                    const int row = row0 + ai * HALF + m * 16; const int pos = row < 16384 ? row : ((row - 16384) & 4095);
                    const float* tp = rope + (size_t)pos * 64 + 8 * fq;
                    const f32x4 c0 = *(const f32x4*)(tp), c1 = *(const f32x4*)(tp + 4), s0 = *(const f32x4*)(tp + 32), s1 = *(const f32x4*)(tp + 36);
                    const f32x4 x1a = acc[ai][0][m][0], x1b = acc[ai][0][m][1], x2a = acc[ai][1][m][0], x2b = acc[ai][1][m][1];
                    const f32x4 o1a = x1a * c0 - x2a * s0, o1b = x1b * c1 - x2b * s1, o2a = x1a * s0 + x2a * c0, o2b = x1b * s1 + x2b * c1;
                    bf16_t* rp = dst + (size_t)row * 512 + head * 64 + 8 * fq;
                    u32x4 w1; w1.x = pk(o1a[0], o1a[1]); w1.y = pk(o1a[2], o1a[3]); w1.z = pk(o1b[0], o1b[1]); w1.w = pk(o1b[2], o1b[3]);
                    u32x4 w2; w2.x = pk(o2a[0], o2a[1]); w2.y = pk(o2a[2], o2a[3]); w2.z = pk(o2b[0], o2b[1]); w2.w = pk(o2b[2], o2b[3]);
                    *(u32x4*)rp = w1; *(u32x4*)(rp + 32) = w2; }
        } else if (pn < 12) {
            const int colb = (pn - 4) * 128 + wc * 32 + 8 * fq;
#pragma unroll
            for (int ai = 0; ai < 2; ++ai)
#pragma unroll
                for (int m = 0; m < 4; ++m) {
                    const int row = row0 + ai * HALF + m * 16; float o[8];
#pragma unroll
                    for (int n = 0; n < 2; ++n)
#pragma unroll
                        for (int j = 0; j < 4; ++j) { const float g = acc[ai][0][m][n][j], gr = acc[ai][1][m][n][j]; o[4 * n + j] = g * sigm(g) * sigm(gr); }
                    u32x4 w; w.x = pk(o[0], o[1]); w.y = pk(o[2], o[3]); w.z = pk(o[4], o[5]); w.w = pk(o[6], o[7]);
                    *(u32x4*)(G1 + (size_t)row * 1024 + colb) = w; }
        } else {
            const bool sg = pn >= 16; bf16_t* dst = sg ? SGP : U; const int col0 = ((pn - 12) & 3) * BM + wc * 32 + 8 * fq;
#pragma unroll
            for (int ai = 0; ai < 2; ++ai)
#pragma unroll
                for (int m = 0; m < 4; ++m) { bf16_t* rowp = dst + (size_t)(row0 + ai * HALF + m * 16) * 1024 + col0;
#pragma unroll
                    for (int bj = 0; bj < 2; ++bj) { f32x4 v0 = acc[ai][bj][m][0], v1 = acc[ai][bj][m][1];
                        if (sg) {
#pragma unroll
                            for (int j = 0; j < 4; ++j) { v0[j] = sigm(v0[j]); v1[j] = sigm(v1[j]); } }
                        u32x4 w; w.x = pk(v0[0], v0[1]); w.y = pk(v0[2], v0[3]); w.z = pk(v1[0], v1[1]); w.w = pk(v1[2], v1[3]);
                        *(u32x4*)(rowp + bj * HALF) = w; } }
        }
    }
};

template <class Epi, class Sched, bool STAMP = false>
__device__ __forceinline__ void gemm_phase(PG8_LAS unsigned char* lds, const Gemm g, const Sched& S, const Epi& E, unsigned long long* stamps) {
    int tid_l = threadIdx.x; asm volatile("" : "+v"(tid_l)); const int tid = tid_l, wid = __builtin_amdgcn_readfirstlane(tid >> 6), lane = tid & 63, wr = wid >> 2, wc = wid & 3, fr = lane & 15, fq = lane >> 4;
    const int K = g.K, nt = K / BK;
    int ts_lo = 0, ts_hi = 0, nts = 0; const unsigned long long rt_entry = STAMP ? (unsigned long long)wall_clock64() : 0ull;
#define PG8_STAMP() do { if (STAMP && wid == 0 && nts < 64) { const unsigned long long _c = (unsigned long long)clock64(); \
        ts_lo = (lane == nts) ? (int)(unsigned)_c : ts_lo; ts_hi = (lane == nts) ? (int)(unsigned)(_c >> 32) : ts_hi; ++nts; } } while (0)
    PG8_STAMP();
    unsigned voffA[2], voffB[2];
#pragma unroll
    for (int i = 0; i < 2; ++i) { int R, C; stage_rc(tid * 16 + i * 8192, R, C); const int Rb = Epi::PERM ? ((R & ~31) + perm32(R & 31)) : R;
        voffA[i] = (unsigned)(R * K + C) * 2u; voffB[i] = (unsigned)(Rb * K + C) * 2u; }
    const size_t kstep = (size_t)(BK * 2);
    const size_t hstep = (size_t)HALF * K * 2;
    const size_t tstep = 2 * hstep;
    const unsigned ldsw = (unsigned)wid * 1024u;
    const int aoff = lds_byte(wr * 64 + fr, fq * 8), boff = lds_byte(wc * 32 + fr, fq * 8);
#define PG8_SA(b, h) (((b) * 2 + (h)) * HTB)
#define PG8_SB(b, h) ((4 + (b) * 2 + (h)) * HTB)
#define PG8_STAGE(bufoff, gbase, voff) do { _Pragma("unroll") for (int _i = 0; _i < 2; ++_i) \
        __builtin_amdgcn_global_load_lds((const unsigned*)((const char*)(gbase) + (voff)[_i]), (PG8_LAS unsigned*)(lds + (bufoff) + ldsw + _i * 8192), 16, 0, 0); } while (0)
#define PG8_LDA(dst, b, h) do { _Pragma("unroll") for (int m = 0; m < 4; ++m) _Pragma("unroll") for (int k = 0; k < 2; ++k) dst[m][k] = *(const PG8_LAS bf16x8*)(lds + PG8_SA(b, h) + aoff + m * 2048 + k * 1024); } while (0)
#define PG8_LDB(dst, b, h) do { _Pragma("unroll") for (int n = 0; n < 2; ++n) _Pragma("unroll") for (int k = 0; k < 2; ++k) dst[n][k] = *(const PG8_LAS bf16x8*)(lds + PG8_SB(b, h) + boff + n * 2048 + k * 1024); } while (0)
#define PG8_MMA(ai, bj, At, Bt) do { __builtin_amdgcn_s_setprio(1); _Pragma("unroll") for (int m = 0; m < 4; ++m) _Pragma("unroll") for (int n = 0; n < 2; ++n) _Pragma("unroll") for (int k = 0; k < 2; ++k) \
        acc[ai][bj][m][n] = __builtin_amdgcn_mfma_f32_16x16x32_bf16(Bt[n][k], At[m][k], acc[ai][bj][m][n], 0, 0, 0); __builtin_amdgcn_s_setprio(0); } while (0)
#define PG8_WAIT_V(n) asm volatile("s_waitcnt vmcnt(" #n ")" ::: "memory")
#define PG8_WAIT_L(n) asm volatile("s_waitcnt lgkmcnt(" #n ")" ::: "memory")
#define PG8_BAR __builtin_amdgcn_s_barrier()
#define PG8_SCHED __builtin_amdgcn_sched_barrier(0)
    Unit cur, nxt; int ui = 0;
    if (!S.next(0, cur)) return;
    f32x4 acc[2][2][4][2];
#pragma unroll
    for (int a = 0; a < 2; ++a)
#pragma unroll
        for (int b = 0; b < 2; ++b)
#pragma unroll
            for (int m = 0; m < 4; ++m)
#pragma unroll
                for (int n = 0; n < 2; ++n) acc[a][b][m][n] = (f32x4){0.f, 0.f, 0.f, 0.f};
    bf16x8 At[4][2], B0[2][2], B1[2][2];
    const char* cA = (const char*)g.A + (size_t)cur.pm * tstep; const char* cB = (const char*)g.Bt + (size_t)cur.pn * tstep;
    S.a_ready(cur);
    PG8_STAGE(PG8_SB(0, 0), cB, voffB); PG8_STAGE(PG8_SA(0, 0), cA, voffA); PG8_STAGE(PG8_SB(0, 1), cB + hstep, voffB); PG8_STAGE(PG8_SA(0, 1), cA + hstep, voffA);
    if (wr == 1) PG8_BAR;
    PG8_WAIT_V(4); PG8_BAR;
    PG8_STAGE(PG8_SB(1, 0), cB + kstep, voffB); PG8_STAGE(PG8_SA(1, 0), cA + kstep, voffA); PG8_STAGE(PG8_SB(1, 1), cB + hstep + kstep, voffB);
    PG8_WAIT_V(6); PG8_BAR;
    PG8_STAMP();
    for (;;) {
        const bool has_next = S.next(ui + 1, nxt);
        const char* nA = has_next ? (const char*)g.A + (size_t)nxt.pm * tstep : cA; const char* nB = has_next ? (const char*)g.Bt + (size_t)nxt.pn * tstep : cB;
        for (int t = 0; t < nt; t += 2) {
            const bool last = (t == nt - 2);
            const char* a1 = cA + (size_t)(t + 1) * kstep;
            const char* a2 = last ? nA : cA + (size_t)(t + 2) * kstep; const char* b2 = last ? nB : cB + (size_t)(t + 2) * kstep;
            const char* a3 = a2 + kstep; const char* b3 = b2 + kstep;
            if (last && has_next) S.a_ready(nxt);
            PG8_LDB(B0, 0, 0); PG8_SCHED; PG8_LDA(At, 0, 0); PG8_STAGE(PG8_SA(1, 1), a1 + hstep, voffA);
            PG8_WAIT_L(8); PG8_BAR; PG8_WAIT_L(0); PG8_MMA(0, 0, At, B0); PG8_BAR; PG8_SCHED;
            PG8_LDB(B1, 0, 1); PG8_STAGE(PG8_SB(0, 0), b2, voffB);
            PG8_BAR; PG8_WAIT_L(0); PG8_MMA(0, 1, At, B1); PG8_BAR;
            PG8_LDA(At, 0, 1); PG8_STAGE(PG8_SA(0, 0), a2, voffA);
            PG8_BAR; PG8_WAIT_L(0); PG8_MMA(1, 0, At, B0); PG8_BAR; PG8_SCHED;
            PG8_STAGE(PG8_SB(0, 1), b2 + hstep, voffB);
            PG8_WAIT_V(6); PG8_BAR; PG8_MMA(1, 1, At, B1); PG8_BAR;
            PG8_LDB(B0, 1, 0); PG8_SCHED; PG8_LDA(At, 1, 0); PG8_STAGE(PG8_SA(0, 1), a2 + hstep, voffA);
            PG8_WAIT_L(8); PG8_BAR; PG8_WAIT_L(0); PG8_MMA(0, 0, At, B0); PG8_BAR; PG8_SCHED;
            PG8_LDB(B1, 1, 1); PG8_STAGE(PG8_SB(1, 0), b3, voffB);
            PG8_BAR; PG8_WAIT_L(0); PG8_MMA(0, 1, At, B1); PG8_BAR;
            PG8_LDA(At, 1, 1); PG8_STAGE(PG8_SA(1, 0), a3, voffA);
            PG8_BAR; PG8_WAIT_L(0); PG8_MMA(1, 0, At, B0); PG8_BAR; PG8_SCHED;
            PG8_STAGE(PG8_SB(1, 1), b3 + hstep, voffB);
            PG8_WAIT_V(6); PG8_BAR; PG8_MMA(1, 1, At, B1); PG8_BAR;
        }
        PG8_STAMP();
        if constexpr (!Epi::AFTER_DRAIN) { E(acc, cur, wr, wc, fr, fq); S.done(cur); }
        PG8_STAMP();
        if (!has_next) break;
#pragma unroll
        for (int a = 0; a < 2; ++a)
#pragma unroll
            for (int b = 0; b < 2; ++b)
#pragma unroll
                for (int m = 0; m < 4; ++m)
#pragma unroll
                    for (int n = 0; n < 2; ++n) acc[a][b][m][n] = (f32x4){0.f, 0.f, 0.f, 0.f};
        cur = nxt; cA = nA; cB = nB; ++ui;
    }
    PG8_WAIT_V(0);
    if (wr == 0) PG8_BAR;
    PG8_BAR;
    if constexpr (Epi::AFTER_DRAIN) { E.fused(acc, cur, wr, wc, fr, fq, lds, wid, lane); S.done(cur); }
    PG8_STAMP();
    if (STAMP && wid == 0) { stamps[lane] = lane < nts ? (((unsigned long long)(unsigned)ts_hi << 32) | (unsigned)ts_lo) : 0ull;
        if (lane == 62) stamps[62] = rt_entry; if (lane == 63) stamps[63] = (unsigned long long)wall_clock64(); }
#undef PG8_STAMP
#undef PG8_SA
#undef PG8_SB
#undef PG8_STAGE
#undef PG8_LDA
#undef PG8_LDB
#undef PG8_MMA
#undef PG8_WAIT_V
#undef PG8_WAIT_L
#undef PG8_BAR
#undef PG8_SCHED
}
}

#define DI __device__ __forceinline__
#define LAS __attribute__((address_space(3)))
typedef unsigned short bf16_t;
typedef short bf16x8 __attribute__((ext_vector_type(8)));
typedef float f32x4 __attribute__((ext_vector_type(4)));
typedef unsigned u32x4 __attribute__((ext_vector_type(4)));
typedef unsigned u32x2 __attribute__((ext_vector_type(2)));
using pg8::pk;
using pg8::sigm;

constexpr int DM = 1024, DEPTH = 4, SEQ_P = 16384, SEQ_S = 4096;
constexpr int MTOK = 81920, DIN = 6144, DFF = 4096, NWIN = 5120;
constexpr int NUNIT_R = 1280;
constexpr size_t MiB = 1u << 20;
constexpr size_t WS_ROPE = 1 * MiB, WS_BTIN = 6 * MiB, WS_WVT = 16 * MiB, WS_BTO = 18 * MiB, WS_BT1 = 20 * MiB, WS_BT2 = 28 * MiB;
constexpr size_t WS_HM = 40 * MiB, WS_Q = 200 * MiB, WS_K = 280 * MiB, WS_VT = 360 * MiB, WS_G1 = 520 * MiB, WS_U = 680 * MiB, WS_SGP = 840 * MiB, WS_END = 1000 * MiB;
constexpr size_t WS_Y = WS_Q, WS_F = WS_VT, WS_ST = WS_HM;
constexpr int LDS_BYTES = 147456;
#ifndef PH
#define PH 255
#endif
constexpr int L_QS = 0, L_KS = 18432, L_VT = 36864, L_KT = 71680, L_FF = 89088, L_FB = 107520, L_OS = 0, L_US = 36864, L_KT2 = 89088;

__device__ const double ROPE_INV[32] = {1.0, 0.7498942093324559, 0.5623413251903491, 0.4216965034285822, 0.31622776601683794, 0.23713737056616552, 0.1778279410038923, 0.1333521432163324, 0.1, 0.07498942093324558, 0.05623413251903491, 0.042169650342858224, 0.03162277660168379, 0.023713737056616554, 0.01778279410038923, 0.01333521432163324, 0.01, 0.007498942093324558, 0.005623413251903491, 0.004216965034285823, 0.0031622776601683794, 0.0023713737056616554, 0.0017782794100389228, 0.001333521432163324, 0.001, 0.0007498942093324559, 0.0005623413251903491, 0.00042169650342858224, 0.00031622776601683794, 0.00023713737056616554, 0.00017782794100389227, 0.0001333521432163324};

struct Params { const float* in[15]; float* out; unsigned char* ws; };


typedef const __attribute__((address_space(4))) unsigned char* kargp_t;
DI kargp_t kargs() { kargp_t k = (kargp_t)__builtin_amdgcn_kernarg_segment_ptr(); asm volatile("" : "+s"(k)); return k; }
DI const float* arg_in(int i) { return *(const float* const __attribute__((address_space(4)))*)(kargs() + 8 * i); }
DI float* arg_out() { return *(float* const __attribute__((address_space(4)))*)(kargs() + 120); }
DI unsigned char* arg_ws() { return *(unsigned char* const __attribute__((address_space(4)))*)(kargs() + 128); }

DI float bflo(unsigned w) { return __uint_as_float(w << 16); }
DI float bfhi(unsigned w) { return __uint_as_float(w & 0xffff0000u); }
DI float ex2(float x) { return __builtin_amdgcn_exp2f(x); }
DI float wave_sum(float v) {
#pragma unroll
    for (int o = 1; o < 64; o <<= 1) v += __shfl_xor(v, o);
    return v;
}
DI f32x4 mfma16(bf16x8 x, bf16x8 y, f32x4 c) { return __builtin_amdgcn_mfma_f32_16x16x32_bf16(x, y, c, 0, 0, 0); }
DI bf16x8 as_bf(u32x4 v) { return __builtin_bit_cast(bf16x8, v); }
DI float log2_gamma(float x) { return -log1pf(__expf(-x)) * 1.4426950408889634f; }

DI void tr_item(const float* Wsrc, int ldw, int k0, bf16_t* dst, int Kd, const float* gain, float scale, LAS float* scr, int lane) {
#pragma unroll 8
    for (int i = 0; i < 32; ++i) { const int kk = 2 * i + (lane >> 5); float v = Wsrc[(size_t)(k0 + kk) * ldw + (lane & 31)] * scale; if (gain) v *= gain[k0 + kk]; scr[kk * 33 + (lane & 31)] = v; }
    asm volatile("s_waitcnt lgkmcnt(0)" ::: "memory");
    const int c = lane & 7;
#pragma unroll
    for (int j = 0; j < 4; ++j) { const int n = (lane >> 3) + 8 * j; const LAS float* s = scr + (8 * c) * 33 + n;
        u32x4 o; o.x = pk(s[0 * 33], s[1 * 33]); o.y = pk(s[2 * 33], s[3 * 33]); o.z = pk(s[4 * 33], s[5 * 33]); o.w = pk(s[6 * 33], s[7 * 33]);
        *(u32x4*)(dst + (size_t)n * Kd + k0 + 8 * c) = o; }
    asm volatile("s_waitcnt lgkmcnt(0)" ::: "memory");
}

DI void convert_layer(int l, LAS unsigned char* lds, int gw, int NGW, int wave, int lane) {
    unsigned char* ws = arg_ws();
    LAS float* scr = (LAS float*)(lds + wave * 16384);
    const float* win = arg_in(4) + (size_t)l * DM * DIN; const float* gpre = arg_in(2) + l * DM;
    const float* wout = arg_in(10) + (size_t)l * DM * DM; const float* gmlp = arg_in(11) + l * DM;
    const float* w1 = arg_in(13) + (size_t)l * DM * DFF; const float* w2 = arg_in(14) + (size_t)l * DFF * DM;
    const float* pw = arg_in(8) + (size_t)l * 4 * 256 * 256; const float* psc = arg_in(9) + l * DM;
    bf16_t* BTin = (bf16_t*)(ws + WS_BTIN); bf16_t* WvT = (bf16_t*)(ws + WS_WVT); bf16_t* BTo = (bf16_t*)(ws + WS_BTO);
    bf16_t* BT1 = (bf16_t*)(ws + WS_BT1); bf16_t* BT2 = (bf16_t*)(ws + WS_BT2);
    for (int it = gw; it < 9216; it += NGW) {
        if (it < 2048) {
            const int sg = it >> 4, kb = it & 15; const int slot0 = sg < 96 ? sg * 32 : 4096 + (sg - 96) * 32;
            const int pn = slot0 >> 8, t = slot0 & 255, bj = t >> 7, wcid = (t >> 5) & 3; int src; float sc = 1.f;
            if (pn < 2) src = ((pn & 1) * 4 + wcid) * 64 + 32 * bj;
            else if (pn < 4) { src = 512 + ((pn & 1) * 4 + wcid) * 64 + 32 * bj; sc = 0.125f; }
            else if (pn < 12) src = (bj ? 4096 : 2048) + 128 * (pn - 4) + 32 * wcid;
            else src = 5120 + (slot0 - 4096);
            tr_item(win + src, DIN, 64 * kb, BTin + (size_t)slot0 * DM, DM, gpre, sc, scr, lane);
        } else if (it < 2560) { const int r = it - 2048, nb = r >> 4, kb = r & 15; tr_item(win + 1024 + 32 * nb, DIN, 64 * kb, WvT + (size_t)(32 * nb) * DM, DM, gpre, 1.f, scr, lane);
        } else if (it < 3072) { const int r = it - 2560, nb = r >> 4, kb = r & 15; tr_item(wout + 32 * nb, DM, 64 * kb, BTo + (size_t)(32 * nb) * DM, DM, nullptr, 1.f, scr, lane);
        } else if (it < 5120) { const int r = it - 3072, nb = r >> 4, kb = r & 15; tr_item(w1 + 32 * nb, DFF, 64 * kb, BT1 + (size_t)(32 * nb) * DM, DM, gmlp, 1.f, scr, lane);
        } else if (it < 7168) { const int r = it - 5120, nb = r >> 6, kb = r & 63; tr_item(w2 + 32 * nb, DM, 64 * kb, BT2 + (size_t)(32 * nb) * DFF, DFF, nullptr, 1.f, scr, lane);
        } else {
            const int fi = it - 7168, ng = fi & 15, kg = fi >> 4; const int g = ng >> 2, d = (ng & 3) * 64 + lane, n = 256 * g + d, k0 = 8 * kg;
            const float* pwp = pw + (size_t)g * 65536 + d; const float* wp = win + (size_t)k0 * DIN + 3072 + g * 256;
            float a[8];
#pragma unroll
            for (int kk = 0; kk < 8; ++kk) a[kk] = 0.f;
            for (int c = 0; c < 256; c += 4) {
                const float p0 = pwp[(c + 0) * 256], p1 = pwp[(c + 1) * 256], p2 = pwp[(c + 2) * 256], p3 = pwp[(c + 3) * 256];
#pragma unroll
                for (int kk = 0; kk < 8; ++kk) { const f32x4 wv = *(const f32x4*)(wp + (size_t)kk * DIN + c); a[kk] += wv[0] * p0 + wv[1] * p1 + wv[2] * p2 + wv[3] * p3; }
            }
            const float sn = psc[n];
#pragma unroll
            for (int kk = 0; kk < 8; ++kk) a[kk] *= sn * gpre[k0 + kk];
            u32x4 o; o.x = pk(a[0], a[1]); o.y = pk(a[2], a[3]); o.z = pk(a[4], a[5]); o.w = pk(a[6], a[7]);
            *(u32x4*)(BTin + (size_t)(3072 + n) * DM + k0) = o;
        }
    }
}

DI void e0_phase(const float* xa, const float* xb, bf16_t* H, int gw, int NGW, int lane) {
    for (int m = gw; m < MTOK; m += NGW) {
        const float* xr = m < SEQ_P ? xa + (size_t)m * DM : xb + (size_t)(m - SEQ_P) * DM;
        f32x4 xv[4]; float ss = 0.f;
#pragma unroll
        for (int j = 0; j < 4; ++j) { xv[j] = *(const f32x4*)(xr + 4 * lane + 256 * j); ss += xv[j][0] * xv[j][0] + xv[j][1] * xv[j][1] + xv[j][2] * xv[j][2] + xv[j][3] * xv[j][3]; }
        const float r = rsqrtf(wave_sum(ss) * (1.f / DM) + 1e-6f);
#pragma unroll
        for (int j = 0; j < 4; ++j) { u32x2 o; o.x = pk(xv[j][0] * r, xv[j][1] * r); o.y = pk(xv[j][2] * r, xv[j][3] * r); *(u32x2*)(H + (size_t)m * DM + 4 * lane + 256 * j) = o; }
    }
}
DI void e_phase(const bf16_t* Y, const float* xa, const float* xb, const float* gpost, float* out, bf16_t* H, int gw, int NGW, int lane) {
    f32x4 g[4];
#pragma unroll
    for (int j = 0; j < 4; ++j) g[j] = *(const f32x4*)(gpost + 4 * lane + 256 * j);
    for (int m = gw; m < MTOK; m += NGW) {
        const float* xr = m < SEQ_P ? xa + (size_t)m * DM : xb + (size_t)(m - SEQ_P) * DM;
        f32x4 xv[4], yv[4]; float ss = 0.f;
#pragma unroll
        for (int j = 0; j < 4; ++j) { const u32x2 yb = *(const u32x2*)(Y + (size_t)m * DM + 4 * lane + 256 * j); xv[j] = *(const f32x4*)(xr + 4 * lane + 256 * j);
            yv[j] = (f32x4){bflo(yb.x), bfhi(yb.x), bflo(yb.y), bfhi(yb.y)}; ss += yv[j][0] * yv[j][0] + yv[j][1] * yv[j][1] + yv[j][2] * yv[j][2] + yv[j][3] * yv[j][3]; }
        const float ry = rsqrtf(wave_sum(ss) * (1.f / DM) + 1e-6f); float s1 = 0.f;
#pragma unroll
        for (int j = 0; j < 4; ++j) { xv[j] = xv[j] + yv[j] * ry * g[j]; s1 += xv[j][0] * xv[j][0] + xv[j][1] * xv[j][1] + xv[j][2] * xv[j][2] + xv[j][3] * xv[j][3]; }
#pragma unroll
        for (int j = 0; j < 4; ++j) *(f32x4*)(out + (size_t)m * DM + 4 * lane + 256 * j) = xv[j];
        if (H) {
            const float r1 = rsqrtf(wave_sum(s1) * (1.f / DM) + 1e-6f);
#pragma unroll
            for (int j = 0; j < 4; ++j) { u32x2 o; o.x = pk(xv[j][0] * r1, xv[j][1] * r1); o.y = pk(xv[j][2] * r1, xv[j][3] * r1); *(u32x2*)(H + (size_t)m * DM + 4 * lane + 256 * j) = o; }
        }
    }
}

DI void state_mma(f32x4 (&acc)[4], LAS unsigned char* Kt, LAS unsigned char* Vt, int w, int r, int q) {
#pragma unroll
    for (int s4 = 0; s4 < 4; ++s4) {
        const bf16x8 vy = *(const LAS bf16x8*)(Vt + (16 * w + r) * 272 + (32 * s4 + 8 * q) * 2);
#pragma unroll
        for (int dt = 0; dt < 4; ++dt) { const bf16x8 kx = *(const LAS bf16x8*)(Kt + (16 * dt + r) * 272 + (32 * s4 + 8 * q) * 2); acc[dt] = mfma16(kx, vy, acc[dt]); }
    }
}
DI void write_kt(LAS unsigned char* Kt, const u32x4 ka, const u32x4 kb, float za, float zb, int w, int lane) {
#pragma unroll
    for (int e = 0; e < 8; ++e) { const unsigned wa = ka[e >> 1], wb = kb[e >> 1]; const float a = (e & 1) ? bfhi(wa) : bflo(wa), b = (e & 1) ? bfhi(wb) : bflo(wb);
        *(LAS unsigned*)(Kt + (8 * w + e) * 272 + lane * 4) = pk(a * za, b * zb); }
}
DI void load_k(const bf16_t* Kb, int row0, int h, int w, int lane, u32x4& ka, u32x4& kb) {
    const bf16_t* pk0 = Kb + (size_t)(row0 + 2 * lane) * 512 + h * 64 + 8 * w; ka = *(const u32x4*)pk0; kb = *(const u32x4*)(pk0 + 512);
}
DI void load_vt(const bf16_t* VT, int row0, int h, int tid, u32x4 (&vv)[4]) {
#pragma unroll
    for (int it = 0; it < 4; ++it) { const int item = tid + 512 * it, dv = item >> 4, tg = item & 15; vv[it] = *(const u32x4*)(VT + (size_t)(h * 128 + dv) * MTOK + row0 + 8 * tg); }
}
DI void write_vt(LAS unsigned char* Vt, int tid, const u32x4 (&vv)[4]) {
#pragma unroll
    for (int it = 0; it < 4; ++it) { const int item = tid + 512 * it, dv = item >> 4, tg = item & 15; *(LAS u32x4*)(Vt + dv * 272 + tg * 16) = vv[it]; }
}

DI void r1_phase(LAS unsigned char* lds, const bf16_t* Kb, const bf16_t* VT, f32x4* ST, const float* decf, const float* decb, int G, int bid, int tid) {
    const int lane = tid & 63, w = __builtin_amdgcn_readfirstlane(tid >> 6), r = lane & 15, q = lane >> 4;
    LAS unsigned char* Vt = lds + L_VT; LAS unsigned char* Ktf = lds + L_KT; LAS unsigned char* Ktb = lds + L_KT2;
    for (int u = bid; u < NUNIT_R; u += G) {
        const int seg = u >> 3, h = u & 7;
        const float lf2 = log2_gamma(decf[h]), lb2 = log2_gamma(decb[h]);
        f32x4 accF[4], accB[4];
#pragma unroll
        for (int dt = 0; dt < 4; ++dt) { accF[dt] = (f32x4){0.f, 0.f, 0.f, 0.f}; accB[dt] = (f32x4){0.f, 0.f, 0.f, 0.f}; }
#pragma unroll 1
        for (int c = 0; c < 4; ++c) {
            const int row0 = seg * 512 + c * 128; u32x4 ka, kb, vv[4];
            load_k(Kb, row0, h, w, lane, ka, kb); load_vt(VT, row0, h, tid, vv);
            const float tl = (float)(c * 128 + 2 * lane);
            const float zf0 = ex2((511.f - tl) * lf2), zf1 = ex2((510.f - tl) * lf2), zb0 = ex2(tl * lb2), zb1 = ex2((tl + 1.f) * lb2);
            __syncthreads();
            write_kt(Ktf, ka, kb, zf0, zf1, w, lane); write_kt(Ktb, ka, kb, zb0, zb1, w, lane); write_vt(Vt, tid, vv);
            __syncthreads();
            state_mma(accF, Ktf, Vt, w, r, q); state_mma(accB, Ktb, Vt, w, r, q);
        }
#pragma unroll
        for (int dt = 0; dt < 4; ++dt) { ST[((size_t)u * 2 + 0) * 2048 + tid * 4 + dt] = accF[dt]; ST[((size_t)u * 2 + 1) * 2048 + tid * 4 + dt] = accB[dt]; }
    }
}

#define R3_IDS int tid = tid0; asm volatile("" : "+v"(tid)); const int lane = tid & 63, r = lane & 15, q = lane >> 4; (void)r; (void)q; (void)lane;
DI void r3_phase(LAS unsigned char* lds, const bf16_t* Qb, const bf16_t* Kb, const bf16_t* VT, bf16_t* G1, const bf16_t* U, const bf16_t* SGP, const f32x4* ST, u32x4* BSV,
                 const float* decf, const float* decb, const float* gn, int G, int bid, int tid0) {
    const int w = __builtin_amdgcn_readfirstlane(tid0 >> 6);
    LAS unsigned char* Qs = lds + L_QS; LAS unsigned char* Ks = lds + L_KS; LAS unsigned char* Vt = lds + L_VT; LAS unsigned char* Kt = lds + L_KT;
    LAS unsigned char* Ff = lds + L_FF; LAS unsigned char* Fb = lds + L_FB; LAS unsigned char* Os = lds + L_OS; LAS unsigned char* Us = lds + L_US;
#pragma unroll 1
    for (int u = bid; u < NUNIT_R; u += G) {
        const int seg = u >> 3, h = u & 7;
        const int s_lo = seg < 32 ? 0 : 32 + ((seg - 32) & ~7), s_hi = seg < 32 ? 32 : s_lo + 8;
        const int seqlo = s_lo * 512, seqhi = s_hi * 512;
        const float lf2 = log2_gamma(decf[h]), lb2 = log2_gamma(decb[h]);
        const float cdf = ex2(128.f * lf2), cdb = ex2(128.f * lb2);
        f32x4 accF[4], accB[4];
#pragma unroll
        for (int dt = 0; dt < 4; ++dt) { accF[dt] = (f32x4){0.f, 0.f, 0.f, 0.f}; accB[dt] = (f32x4){0.f, 0.f, 0.f, 0.f}; }
        { R3_IDS
          const float sf = ex2(512.f * lf2); float fac = 1.f;
#pragma unroll 1
          for (int s2 = seg - 1; s2 >= s_lo && fac > 1e-25f; --s2) { const f32x4* sp = ST + ((size_t)(s2 * 8 + h) * 2 + 0) * 2048 + tid * 4;
#pragma unroll
              for (int dt = 0; dt < 4; ++dt) accF[dt] += sp[dt] * fac;
              fac *= sf; }
          const float sb = ex2(512.f * lb2); fac = 1.f;
#pragma unroll 1
          for (int s2 = seg + 1; s2 < s_hi && fac > 1e-25f; ++s2) { const f32x4* sp = ST + ((size_t)(s2 * 8 + h) * 2 + 1) * 2048 + tid * 4;
#pragma unroll
              for (int dt = 0; dt < 4; ++dt) accB[dt] += sp[dt] * fac;
              fac *= sb; } }
#pragma unroll 1
        for (int c = 3; c >= 0; --c) {
            R3_IDS
            { u32x4 p0, p1; p0.x = pk(accB[0][0], accB[0][1]); p0.y = pk(accB[0][2], accB[0][3]); p0.z = pk(accB[1][0], accB[1][1]); p0.w = pk(accB[1][2], accB[1][3]);
              p1.x = pk(accB[2][0], accB[2][1]); p1.y = pk(accB[2][2], accB[2][3]); p1.z = pk(accB[3][0], accB[3][1]); p1.w = pk(accB[3][2], accB[3][3]);
              BSV[(c * 512 + tid) * 2] = p0; BSV[(c * 512 + tid) * 2 + 1] = p1; }
            if (c == 0) break;
            const int row0 = seg * 512 + c * 128; u32x4 ka, kb, vv[4];
            load_k(Kb, row0, h, w, lane, ka, kb); load_vt(VT, row0, h, tid, vv);
            const float tj = (float)(2 * lane); const float zb0 = ex2(tj * lb2), zb1 = ex2((tj + 1.f) * lb2);
            __syncthreads();
            write_kt(Kt, ka, kb, zb0, zb1, w, lane); write_vt(Vt, tid, vv);
            __syncthreads();
#pragma unroll
            for (int dt = 0; dt < 4; ++dt) accB[dt] *= cdb;
            state_mma(accB, Kt, Vt, w, r, q);
        }
        const int half = 1 << (h >> 1);
#pragma unroll 1
        for (int c = 0; c < 4; ++c) {
            const int row0 = seg * 512 + c * 128;
            { R3_IDS
              u32x4 ka, kb, vv[4], qv[2];
              load_k(Kb, row0, h, w, lane, ka, kb); load_vt(VT, row0, h, tid, vv);
#pragma unroll
              for (int it = 0; it < 2; ++it) { const int item = tid + 512 * it, tok = item >> 3, g8 = item & 7; qv[it] = *(const u32x4*)(Qb + (size_t)(row0 + tok) * 512 + h * 64 + 8 * g8); }
              const float tj = (float)(2 * lane); const float zf0 = ex2((127.f - tj) * lf2), zf1 = ex2((126.f - tj) * lf2);
              const u32x4 bs0 = BSV[(c * 512 + tid) * 2], bs1 = BSV[(c * 512 + tid) * 2 + 1];
              __syncthreads();
              write_kt(Kt, ka, kb, zf0, zf1, w, lane); write_vt(Vt, tid, vv);
              *(LAS u32x4*)(Ks + (2 * lane) * 144 + 16 * w) = ka; *(LAS u32x4*)(Ks + (2 * lane + 1) * 144 + 16 * w) = kb;
#pragma unroll
              for (int it = 0; it < 2; ++it) { const int item = tid + 512 * it, tok = item >> 3, g8 = item & 7; *(LAS u32x4*)(Qs + tok * 144 + 16 * g8) = qv[it]; }
#pragma unroll
              for (int dt = 0; dt < 4; ++dt) {
                u32x2 ff; ff.x = pk(accF[dt][0], accF[dt][1]); ff.y = pk(accF[dt][2], accF[dt][3]);
                *(LAS u32x2*)(Ff + (16 * w + r) * 144 + (16 * dt + 4 * q) * 2) = ff;
                u32x2 fb; fb.x = dt < 2 ? bs0[2 * dt] : bs1[2 * dt - 4]; fb.y = dt < 2 ? bs0[2 * dt + 1] : bs1[2 * dt - 3];
                *(LAS u32x2*)(Fb + (16 * w + r) * 144 + (16 * dt + 4 * q) * 2) = fb; }
              __syncthreads(); }
            f32x4 ao[8]; float rs;
            { R3_IDS
              u32x4 qf[2];
#pragma unroll
              for (int s = 0; s < 2; ++s) qf[s] = *(const LAS u32x4*)(Qs + (16 * w + r) * 144 + (32 * s + 8 * q) * 2);
              f32x4 as[8];
#pragma unroll
              for (int jt = 0; jt < 8; ++jt) { as[jt] = (f32x4){0.f, 0.f, 0.f, 0.f};
#pragma unroll
                for (int s = 0; s < 2; ++s) { const bf16x8 kx = *(const LAS bf16x8*)(Ks + (16 * jt + r) * 144 + (32 * s + 8 * q) * 2); as[jt] = mfma16(kx, as_bf(qf[s]), as[jt]); } }
              const int i = 16 * w + r;
#pragma unroll
              for (int jt = 0; jt < 8; ++jt)
#pragma unroll
                for (int jj = 0; jj < 4; ++jj) { const int d = i - (16 * jt + 4 * q + jj); const float fd = (float)d; as[jt][jj] *= ex2(d >= 0 ? fd * lf2 : -fd * lb2); }
              u32x4 pf[4];
#pragma unroll
              for (int s2 = 0; s2 < 4; ++s2) { pf[s2].x = pk(as[2 * s2][0], as[2 * s2][1]); pf[s2].y = pk(as[2 * s2][2], as[2 * s2][3]); pf[s2].z = pk(as[2 * s2 + 1][0], as[2 * s2 + 1][1]); pf[s2].w = pk(as[2 * s2 + 1][2], as[2 * s2 + 1][3]); }
              const float xf = ex2((float)(i + 1) * lf2), xb = ex2((float)(128 - i) * lb2);
              u32x4 qff[2], qbb[2];
#pragma unroll
              for (int s = 0; s < 2; ++s)
#pragma unroll
                for (int k = 0; k < 4; ++k) { const float lo = bflo(qf[s][k]), hi = bfhi(qf[s][k]); qff[s][k] = pk(lo * xf, hi * xf); qbb[s][k] = pk(lo * xb, hi * xb); }
              __builtin_amdgcn_sched_barrier(0);
#pragma unroll
              for (int t = 0; t < 8; ++t) { ao[t] = (f32x4){0.f, 0.f, 0.f, 0.f};
#pragma unroll
                for (int s2 = 0; s2 < 4; ++s2) { const u32x2 lo = *(const LAS u32x2*)(Vt + (16 * t + r) * 272 + (32 * s2 + 4 * q) * 2), hi = *(const LAS u32x2*)(Vt + (16 * t + r) * 272 + (32 * s2 + 16 + 4 * q) * 2);
                    const u32x4 vx = {lo.x, lo.y, hi.x, hi.y}; ao[t] = mfma16(as_bf(vx), as_bf(pf[s2]), ao[t]); }
#pragma unroll
                for (int s = 0; s < 2; ++s) { const bf16x8 fx = *(const LAS bf16x8*)(Ff + (16 * t + r) * 144 + (32 * s + 8 * q) * 2); ao[t] = mfma16(fx, as_bf(qff[s]), ao[t]);
                    const bf16x8 bx = *(const LAS bf16x8*)(Fb + (16 * t + r) * 144 + (32 * s + 8 * q) * 2); ao[t] = mfma16(bx, as_bf(qbb[s]), ao[t]); }
                if (t & 1) __builtin_amdgcn_sched_barrier(0); }
              if (c < 3) {
#pragma unroll
                for (int dt = 0; dt < 4; ++dt) accF[dt] *= cdf;
                state_mma(accF, Kt, Vt, w, r, q); }
              __builtin_amdgcn_sched_barrier(0);
              float s1 = 0.f;
#pragma unroll
              for (int t = 0; t < 8; ++t) s1 += (ao[t][0] + ao[t][1]) + (ao[t][2] + ao[t][3]);
              s1 += __shfl_xor(s1, 16); s1 += __shfl_xor(s1, 32);
              const float mu = s1 * (1.f / 128.f); float s2v = 0.f;
#pragma unroll
              for (int t = 0; t < 8; ++t) { ao[t] = ao[t] - mu; s2v += (ao[t][0] * ao[t][0] + ao[t][1] * ao[t][1]) + (ao[t][2] * ao[t][2] + ao[t][3] * ao[t][3]); }
              s2v += __shfl_xor(s2v, 16); s2v += __shfl_xor(s2v, 32);
              rs = rsqrtf(s2v * (1.f / 128.f) + 1e-6f);
              __syncthreads(); }
            { R3_IDS
#pragma unroll
              for (int t = 0; t < 8; ++t) { u32x2 o; o.x = pk(ao[t][0] * rs, ao[t][1] * rs); o.y = pk(ao[t][2] * rs, ao[t][3] * rs); *(LAS u32x2*)(Os + (16 * w + r) * 272 + (16 * t + 4 * q) * 2) = o; }
#pragma unroll
              for (int it = 0; it < 5; ++it) { const int item = tid + 512 * it, rr = item >> 4, cgp = item & 15, grow = row0 - 8 + rr;
                if (item < 2304 && grow >= seqlo && grow < seqhi) *(LAS u32x4*)(Us + rr * 272 + cgp * 16) = *(const u32x4*)(U + (size_t)grow * DM + h * 128 + 8 * cgp); }
              __syncthreads(); }
#pragma unroll 1
            for (int it = 0; it < 4; ++it) {
                R3_IDS
                const int item = tid + 512 * it, tok = item >> 4, cgp = item & 15, grow = row0 + tok;
                const size_t goff = (size_t)grow * DM + h * 128 + 8 * cgp;
                const u32x4 g1 = *(const u32x4*)(G1 + goff), sg = *(const u32x4*)(SGP + goff);
                const f32x4 ga = *(const f32x4*)(gn + h * 128 + 8 * cgp), gb = *(const f32x4*)(gn + h * 128 + 8 * cgp + 4);
                const u32x4 on = *(const LAS u32x4*)(Os + tok * 272 + cgp * 16);
                const int lo = max(grow - half, seqlo), hi = min(grow + half, seqhi);
                float a8[8];
#pragma unroll
                for (int k = 0; k < 8; ++k) a8[k] = 0.f;
#pragma unroll 1
                for (int t = lo; t < hi; ++t) { const u32x4 uw = *(const LAS u32x4*)(Us + (t - row0 + 8) * 272 + cgp * 16);
#pragma unroll
                    for (int k = 0; k < 4; ++k) { a8[2 * k] += bflo(uw[k]); a8[2 * k + 1] += bfhi(uw[k]); } }
                const u32x4 own = *(const LAS u32x4*)(Us + (tok + 8) * 272 + cgp * 16);
                const float inv = 1.f / (float)(hi - lo);
                float mo[8];
#pragma unroll
                for (int k = 0; k < 4; ++k) {
                    const float gl = k < 2 ? ga[2 * k] : gb[2 * k - 4], gh = k < 2 ? ga[2 * k + 1] : gb[2 * k - 3];
                    mo[2 * k] = bflo(g1[k]) * bflo(on[k]) * gl + bflo(sg[k]) * (a8[2 * k] * inv - bflo(own[k]));
                    mo[2 * k + 1] = bfhi(g1[k]) * bfhi(on[k]) * gh + bfhi(sg[k]) * (a8[2 * k + 1] * inv - bfhi(own[k])); }
                u32x4 o; o.x = pk(mo[0], mo[1]); o.y = pk(mo[2], mo[3]); o.z = pk(mo[4], mo[5]); o.w = pk(mo[6], mo[7]);
                *(u32x4*)(G1 + goff) = o;
            }
        }
    }
}

__global__ void __launch_bounds__(512, 2) fwd_megakernel(Params p) {
    extern __shared__ __attribute__((aligned(16))) unsigned char lds_raw[];
    LAS unsigned char* lds = (LAS unsigned char*)lds_raw;
    cg::grid_group grid = cg::this_grid();
#define FRESH_IDS int tid = threadIdx.x; asm volatile("" : "+v"(tid)); const int lane = tid & 63, wave = __builtin_amdgcn_readfirstlane(tid >> 6); const int G = gridDim.x, bid = blockIdx.x, gw = bid * 8 + wave, NGW = G * 8; (void)lane; (void)gw; (void)NGW;
#define WSB(T, off) ((T*)(arg_ws() + (off)))

    { FRESH_IDS float* rope = WSB(float, WS_ROPE);
      for (int e = bid * 512 + tid; e < SEQ_P * 32; e += G * 512) {
        const int pos = e >> 5, i = e & 31; double rev = (double)pos * ROPE_INV[i] * 0.15915494309189535; rev -= floor(rev); const float rf = (float)rev;
        rope[pos * 64 + i] = __builtin_amdgcn_cosf(rf); rope[pos * 64 + 32 + i] = __builtin_amdgcn_sinf(rf); } }
#if PH & 1
    { FRESH_IDS convert_layer(0, lds, gw, NGW, wave, lane); }
#endif
    { FRESH_IDS e0_phase(arg_in(0), arg_in(1), WSB(bf16_t, WS_HM), gw, NGW, lane); }
    grid.sync();

#pragma unroll 1
    for (int l = 0; l < DEPTH; ++l) {
#if PH & 2
        { FRESH_IDS unsigned char* ws = arg_ws();
          pg8::Gemm g{(bf16_t*)(ws + WS_HM), (bf16_t*)(ws + WS_BTIN), MTOK, NWIN, DM}; pg8::StaticOrder S; S.init(MTOK, NWIN, G, bid);
          pg8::EpiWin E{(bf16_t*)(ws + WS_Q), (bf16_t*)(ws + WS_K), (bf16_t*)(ws + WS_G1), (bf16_t*)(ws + WS_U), (bf16_t*)(ws + WS_SGP), (const float*)(ws + WS_ROPE)};
          pg8::gemm_phase<pg8::EpiWin, pg8::StaticOrder>(lds, g, S, E, nullptr); }
#endif
#if PH & 4
        { FRESH_IDS unsigned char* ws = arg_ws();
          pg8::Gemm g{(bf16_t*)(ws + WS_WVT), (bf16_t*)(ws + WS_HM), DM, MTOK, DM}; pg8::StaticOrder S; S.init(DM, MTOK, G, bid);
          pg8::EpiBf<0> E{(bf16_t*)(ws + WS_VT), (size_t)MTOK};
          pg8::gemm_phase<pg8::EpiBf<0>, pg8::StaticOrder>(lds, g, S, E, nullptr); }
#endif
        grid.sync();
#if PH & 8
        { FRESH_IDS unsigned char* ws = arg_ws();
          r1_phase(lds, (const bf16_t*)(ws + WS_K), (const bf16_t*)(ws + WS_VT), (f32x4*)(ws + WS_ST), arg_in(5) + l * 8, arg_in(6) + l * 8, G, bid, tid); }
#endif
        grid.sync();
#if PH & 16
        { FRESH_IDS unsigned char* ws = arg_ws();
          r3_phase(lds, (const bf16_t*)(ws + WS_Q), (const bf16_t*)(ws + WS_K), (const bf16_t*)(ws + WS_VT), (bf16_t*)(ws + WS_G1), (const bf16_t*)(ws + WS_U), (const bf16_t*)(ws + WS_SGP),
                   (const f32x4*)(ws + WS_ST), (u32x4*)(ws + WS_ST + 96 * MiB) + (size_t)bid * 4096, arg_in(5) + l * 8, arg_in(6) + l * 8, arg_in(7) + l * DM, G, bid, tid); }
#endif
        grid.sync();
#if PH & 32
        { FRESH_IDS unsigned char* ws = arg_ws();
          pg8::Gemm g{(bf16_t*)(ws + WS_G1), (bf16_t*)(ws + WS_BTO), MTOK, DM, DM}; pg8::StaticOrder S; S.init(MTOK, DM, G, bid);
          pg8::EpiBf<0> E{(bf16_t*)(ws + WS_Y), (size_t)DM};
          pg8::gemm_phase<pg8::EpiBf<0>, pg8::StaticOrder>(lds, g, S, E, nullptr); }
#endif
        grid.sync();
        { FRESH_IDS float* out = arg_out();
          e_phase(WSB(bf16_t, WS_Y), l == 0 ? arg_in(0) : out, l == 0 ? arg_in(1) : out + (size_t)SEQ_P * DM, arg_in(3) + l * DM, out, WSB(bf16_t, WS_HM), gw, NGW, lane); }
        grid.sync();
#if PH & 64
        { FRESH_IDS unsigned char* ws = arg_ws();
          pg8::Gemm g{(bf16_t*)(ws + WS_HM), (bf16_t*)(ws + WS_BT1), MTOK, DFF, DM}; pg8::StaticOrder S; S.init(MTOK, DFF, G, bid);
          pg8::EpiBf<1> E{(bf16_t*)(ws + WS_F), (size_t)DFF};
          pg8::gemm_phase<pg8::EpiBf<1>, pg8::StaticOrder>(lds, g, S, E, nullptr); }
#endif
        grid.sync();
#if PH & 128
        { FRESH_IDS unsigned char* ws = arg_ws();
          pg8::Gemm g{(bf16_t*)(ws + WS_F), (bf16_t*)(ws + WS_BT2), MTOK, DM, DFF}; pg8::StaticOrder S; S.init(MTOK, DM, G, bid);
          pg8::EpiBf<0> E{(bf16_t*)(ws + WS_Y), (size_t)DM};
          pg8::gemm_phase<pg8::EpiBf<0>, pg8::StaticOrder>(lds, g, S, E, nullptr); }
#endif
        grid.sync();
        { FRESH_IDS float* out = arg_out();
          e_phase(WSB(bf16_t, WS_Y), out, out + (size_t)SEQ_P * DM, arg_in(12) + l * DM, out, l + 1 < DEPTH ? WSB(bf16_t, WS_HM) : nullptr, gw, NGW, lane); }
        if (l + 1 < DEPTH) {
#if PH & 1
            { FRESH_IDS convert_layer(l + 1, lds, gw, NGW, wave, lane); }
#endif
            grid.sync(); }
    }
}

extern "C" void kernel_launch(void* const* d_in, const int* in_sizes, int n_in, void* d_out, int out_size, void* d_ws, size_t ws_size, hipStream_t stream) {
    static int grid = 0;
    if (grid == 0) {
        if (n_in != 15 || out_size != MTOK * DM || ws_size < WS_END) { fprintf(stderr, "kernel_launch: unexpected shapes (n_in %d, out %d, ws %zu)\n", n_in, out_size, ws_size); grid = -1; return; }
        int dev = 0, cus = 0, per_cu = 0;
        hipGetDevice(&dev); hipDeviceGetAttribute(&cus, hipDeviceAttributeMultiprocessorCount, dev);
        if (hipFuncSetAttribute((const void*)fwd_megakernel, hipFuncAttributeMaxDynamicSharedMemorySize, LDS_BYTES) != hipSuccess) { fprintf(stderr, "kernel_launch: hipFuncSetAttribute failed\n"); grid = -1; return; }
        if (hipOccupancyMaxActiveBlocksPerMultiprocessor(&per_cu, (const void*)fwd_megakernel, 512, LDS_BYTES) != hipSuccess || per_cu < 1) { fprintf(stderr, "kernel_launch: occupancy query failed (%d)\n", per_cu); (void)hipGetLastError(); per_cu = 1; }
        grid = cus * per_cu;
    }
    if (grid < 0) return;
    Params p{};
    for (int i = 0; i < 15; ++i) p.in[i] = (const float*)d_in[i];
    p.out = (float*)d_out; p.ws = (unsigned char*)d_ws;
    void* args[] = {&p};
    hipError_t e = hipLaunchCooperativeKernel((const void*)fwd_megakernel, dim3(grid), dim3(512), args, LDS_BYTES, stream);
    if (e != hipSuccess) fprintf(stderr, "kernel_launch: cooperative launch failed: %s (grid %d)\n", hipGetErrorString(e), grid);
}
```

```cpp
#include <hip/hip_runtime.h>
#include <hip/hip_cooperative_groups.h>
#include <cstdio>
#include <cstdint>
namespace cg = cooperative_groups;
namespace pg8 {
#define PG8_LAS __attribute__((address_space(3)))
typedef unsigned short bf16_t;
typedef short bf16x8 __attribute__((ext_vector_type(8)));
typedef float f32x4 __attribute__((ext_vector_type(4)));
typedef unsigned u32x4 __attribute__((ext_vector_type(4)));
constexpr int BM = 256, BK = 64, HALF = 128, HTB = HALF * BK * 2  , STAGE_BYTES = 8 * HTB, NXCD = 8, WGM = 8;

__host__ __device__ __forceinline__ int lds_byte(int r, int c) { const int st = (r >> 4) * 2 + (c >> 5), rr = r & 15, cc = c & 31, ob = rr * 64 + cc * 2; return st * 1024 + (ob ^ (((ob >> 9) & 1) << 5)); }
__host__ __device__ __forceinline__ void stage_rc(int b, int& R, int& C) { const int st = b / 1024, sb = b % 1024, swz = sb ^ (((sb >> 9) & 1) << 5); R = (st >> 1) * 16 + swz / 64; C = (st & 1) * 32 + (swz % 64) / 2; }
__host__ __device__ __forceinline__ int perm32(int rho) { const int n = rho >> 4, i = rho & 15; return 8 * (i >> 2) + 4 * n + (i & 3); }

struct Unit { int pm, pn; };
struct Gemm { const bf16_t* A; const bf16_t* Bt; int M, N, K; };

struct StaticOrder {
    int nM, nN, nwg, G, c;
    __host__ __device__ void init(int M, int N, int G_, int c_) { nM = M / BM; nN = N / BM; nwg = nM * nN; G = G_; c = c_; }
    __host__ __device__ bool next(int i, Unit& u) const {
        const long L = (long)i * G + c; if (L >= nwg) return false;
        int wgid = (int)L; { const int q = nwg / NXCD, r = nwg % NXCD, xcd = wgid % NXCD, off = wgid / NXCD; wgid = (xcd < r ? xcd * (q + 1) : r * (q + 1) + (xcd - r) * q) + off; }
        const int nig = WGM * nN, gid = wgid / nig, fm = gid * WGM, gsz = (nM - fm) < WGM ? (nM - fm) : WGM;
        u.pm = fm + ((wgid % nig) % gsz); u.pn = (wgid % nig) / gsz; return true;
    }
    __device__ __forceinline__ void a_ready(const Unit&) const {}
    __device__ __forceinline__ void done(const Unit&) const {}
};

typedef float f32x2 __attribute__((ext_vector_type(2)));
typedef __bf16 bf2_t __attribute__((ext_vector_type(2)));
__device__ __forceinline__ unsigned pk(float lo, float hi) { f32x2 v = {lo, hi}; bf2_t b = __builtin_convertvector(v, bf2_t); return __builtin_bit_cast(unsigned, b); }
__device__ __forceinline__ float sigm(float x) { return __builtin_amdgcn_rcpf(1.0f + __expf(-x)); }

template <int ACT  > struct EpiBf {
    static constexpr bool PERM = true, AFTER_DRAIN = false;
    bf16_t* O; size_t ldc;
    __device__ __forceinline__ void operator()(const f32x4 (&acc)[2][2][4][2], const Unit& u, int wr, int wc, int fr, int fq) const {
        const int row0 = u.pm * BM + wr * 64 + fr; const int col0 = u.pn * BM + wc * 32 + 8 * fq;
#pragma unroll
        for (int ai = 0; ai < 2; ++ai)
#pragma unroll
            for (int m = 0; m < 4; ++m) { bf16_t* rowp = O + (size_t)(row0 + ai * HALF + m * 16) * ldc + col0;
#pragma unroll
                for (int bj = 0; bj < 2; ++bj) { f32x4 v0 = acc[ai][bj][m][0], v1 = acc[ai][bj][m][1];
                    if (ACT == 1) {
#pragma unroll
                        for (int j = 0; j < 4; ++j) { const float a = fmaxf(v0[j], 0.f), b = fmaxf(v1[j], 0.f); v0[j] = a * a; v1[j] = b * b; } }
                    u32x4 w; w.x = pk(v0[0], v0[1]); w.y = pk(v0[2], v0[3]); w.z = pk(v1[0], v1[1]); w.w = pk(v1[2], v1[3]);
                    *(u32x4*)(rowp + bj * HALF) = w; } }
    }
};

struct EpiWin {
    static constexpr bool PERM = true, AFTER_DRAIN = false;
    bf16_t *Q, *Kb, *G1, *U, *SGP; const float* rope;
    __device__ __forceinline__ void operator()(const f32x4 (&acc)[2][2][4][2], const Unit& u, int wr, int wc, int fr, int fq) const {
        const int pn = u.pn; const int row0 = u.pm * BM + wr * 64 + fr;
        if (pn < 4) {
            bf16_t* dst = pn < 2 ? Q : Kb; const int head = (pn & 1) * 4 + wc;
#pragma unroll
            for (int ai = 0; ai < 2; ++ai)
#pragma unroll
                for (int m = 0; m < 4; ++m) {
                    const int row = row0 + ai * HALF + m * 16; const int pos = row < 16384 ? row : ((row - 16384) & 4095);
                    const float* tp = rope + (size_t)pos * 64 + 8 * fq;
                    const f32x4 c0 = *(const f32x4*)(tp), c1 = *(const f32x4*)(tp + 4), s0 = *(const f32x4*)(tp + 32), s1 = *(const f32x4*)(tp + 36);
                    const f32x4 x1a = acc[ai][0][m][0], x1b = acc[ai][0][m][1], x2a = acc[ai][1][m][0], x2b = acc[ai][1][m][1];
                    const f32x4 o1a = x1a * c0 - x2a * s0, o1b = x1b * c1 - x2b * s1, o2a = x1a * s0 + x2a * c0, o2b = x1b * s1 + x2b * c1;
                    bf16_t* rp = dst + (size_t)row * 512 + head * 64 + 8 * fq;
                    u32x4 w1; w1.x = pk(o1a[0], o1a[1]); w1.y = pk(o1a[2], o1a[3]); w1.z = pk(o1b[0], o1b[1]); w1.w = pk(o1b[2], o1b[3]);
                    u32x4 w2; w2.x = pk(o2a[0], o2a[1]); w2.y = pk(o2a[2], o2a[3]); w2.z = pk(o2b[0], o2b[1]); w2.w = pk(o2b[2], o2b[3]);
                    *(u32x4*)rp = w1; *(u32x4*)(rp + 32) = w2; }
        } else if (pn < 12) {
            const int colb = (pn - 4) * 128 + wc * 32 + 8 * fq;
#pragma unroll
            for (int ai = 0; ai < 2; ++ai)
#pragma unroll
                for (int m = 0; m < 4; ++m) {
                    const int row = row0 + ai * HALF + m * 16; float o[8];
#pragma unroll
                    for (int n = 0; n < 2; ++n)
#pragma unroll
                        for (int j = 0; j < 4; ++j) { const float g = acc[ai][0][m][n][j], gr = acc[ai][1][m][n][j]; o[4 * n + j] = g * sigm(g) * sigm(gr); }
                    u32x4 w; w.x = pk(o[0], o[1]); w.y = pk(o[2], o[3]); w.z = pk(o[4], o[5]); w.w = pk(o[6], o[7]);
                    *(u32x4*)(G1 + (size_t)row * 1024 + colb) = w; }
        } else {
            const bool sg = pn >= 16; bf16_t* dst = sg ? SGP : U; const int col0 = ((pn - 12) & 3) * BM + wc * 32 + 8 * fq;
#pragma unroll
            for (int ai = 0; ai < 2; ++ai)
#pragma unroll
                for (int m = 0; m < 4; ++m) { bf16_t* rowp = dst + (size_t)(row0 + ai * HALF + m * 16) * 1024 + col0;
#pragma unroll
                    for (int bj = 0; bj < 2; ++bj) { f32x4 v0 = acc[ai][bj][m][0], v1 = acc[ai][bj][m][1];
                        if (sg) {
#pragma unroll
                            for (int j = 0; j < 4; ++j) { v0[j] = sigm(v0[j]); v1[j] = sigm(v1[j]); } }
                        u32x4 w; w.x = pk(v0[0], v0[1]); w.y = pk(v0[2], v0[3]); w.z = pk(v1[0], v1[1]); w.w = pk(v1[2], v1[3]);
                        *(u32x4*)(rowp + bj * HALF) = w; } }
        }
    }
};

template <class Epi, class Sched, bool ALIGN_EPI = false, bool SP2 = false>
__device__ __forceinline__ void gemm_phase(PG8_LAS unsigned char* lds, const Gemm g, const Sched& S, const Epi& E) {
    int tid_l = threadIdx.x; asm volatile("" : "+v"(tid_l)); const int tid = tid_l, wid = __builtin_amdgcn_readfirstlane(tid >> 6), lane = tid & 63, wr = wid >> 2, wc = wid & 3, fr = lane & 15, fq = lane >> 4;
    const int K = g.K, nt = K / BK;
    unsigned voffA[2], voffB[2];
#pragma unroll
    for (int i = 0; i < 2; ++i) { int R, C; stage_rc(tid * 16 + i * 8192, R, C); const int Rb = Epi::PERM ? ((R & ~31) + perm32(R & 31)) : R;
        voffA[i] = (unsigned)(R * K + C) * 2u; voffB[i] = (unsigned)(Rb * K + C) * 2u; }
    const size_t kstep = (size_t)(BK * 2);
    const size_t hstep = (size_t)HALF * K * 2;
    const size_t tstep = 2 * hstep;
    const unsigned ldsw = (unsigned)wid * 1024u;
    const int aoff = lds_byte(wr * 64 + fr, fq * 8), boff = lds_byte(wc * 32 + fr, fq * 8);
#define PG8_SA(b, h) (((b) * 2 + (h)) * HTB)
#define PG8_SB(b, h) ((4 + (b) * 2 + (h)) * HTB)
#define PG8_STAGE(bufoff, gbase, voff) do { _Pragma("unroll") for (int _i = 0; _i < 2; ++_i) \
        __builtin_amdgcn_global_load_lds((const unsigned*)((const char*)(gbase) + (voff)[_i]), (PG8_LAS unsigned*)(lds + (bufoff) + ldsw + _i * 8192), 16, 0, 0); } while (0)
#define PG8_LDA(dst, b, h) do { _Pragma("unroll") for (int m = 0; m < 4; ++m) _Pragma("unroll") for (int k = 0; k < 2; ++k) dst[m][k] = *(const PG8_LAS bf16x8*)(lds + PG8_SA(b, h) + aoff + m * 2048 + k * 1024); } while (0)
#define PG8_LDB(dst, b, h) do { _Pragma("unroll") for (int n = 0; n < 2; ++n) _Pragma("unroll") for (int k = 0; k < 2; ++k) dst[n][k] = *(const PG8_LAS bf16x8*)(lds + PG8_SB(b, h) + boff + n * 2048 + k * 1024); } while (0)
#define PG8_MMA(ai, bj, At, Bt) do { __builtin_amdgcn_s_setprio(1); _Pragma("unroll") for (int m = 0; m < 4; ++m) _Pragma("unroll") for (int n = 0; n < 2; ++n) _Pragma("unroll") for (int k = 0; k < 2; ++k) \
        acc[ai][bj][m][n] = __builtin_amdgcn_mfma_f32_16x16x32_bf16(Bt[n][k], At[m][k], acc[ai][bj][m][n], 0, 0, 0); __builtin_amdgcn_s_setprio(0); } while (0)
#define PG8_WAIT_V(n) asm volatile("s_waitcnt vmcnt(" #n ")" ::: "memory")
#define PG8_WAIT_L(n) asm volatile("s_waitcnt lgkmcnt(" #n ")" ::: "memory")
#define PG8_BAR __builtin_amdgcn_s_barrier()
#define PG8_SCHED __builtin_amdgcn_sched_barrier(0)
    Unit cur, nxt; int ui = 0;
    if (!S.next(0, cur)) return;
    f32x4 acc[2][2][4][2];
#pragma unroll
    for (int a = 0; a < 2; ++a)
#pragma unroll
        for (int b = 0; b < 2; ++b)
#pragma unroll
            for (int m = 0; m < 4; ++m)
#pragma unroll
                for (int n = 0; n < 2; ++n) acc[a][b][m][n] = (f32x4){0.f, 0.f, 0.f, 0.f};
    bf16x8 At[4][2], B0[2][2], B1[2][2];
    const char* cA = (const char*)g.A + (size_t)cur.pm * tstep; const char* cB = (const char*)g.Bt + (size_t)cur.pn * tstep;
    S.a_ready(cur);
    if constexpr (SP2) {
        PG8_STAGE(PG8_SB(0, 0), cB, voffB); PG8_STAGE(PG8_SB(0, 1), cB + hstep, voffB); PG8_STAGE(PG8_SA(0, 0), cA, voffA); PG8_STAGE(PG8_SA(0, 1), cA + hstep, voffA);
        if (wr == 1) PG8_BAR;
        PG8_WAIT_V(2); PG8_BAR;
        PG8_STAGE(PG8_SB(1, 0), cB + kstep, voffB); PG8_STAGE(PG8_SA(1, 0), cA + kstep, voffA); PG8_STAGE(PG8_SB(1, 1), cB + hstep + kstep, voffB);
        PG8_WAIT_V(6); PG8_BAR;
    } else {
        PG8_STAGE(PG8_SB(0, 0), cB, voffB); PG8_STAGE(PG8_SA(0, 0), cA, voffA); PG8_STAGE(PG8_SB(0, 1), cB + hstep, voffB); PG8_STAGE(PG8_SA(0, 1), cA + hstep, voffA);
        if (wr == 1) PG8_BAR;
        PG8_WAIT_V(4); PG8_BAR;
        PG8_STAGE(PG8_SB(1, 0), cB + kstep, voffB); PG8_STAGE(PG8_SA(1, 0), cA + kstep, voffA); PG8_STAGE(PG8_SB(1, 1), cB + hstep + kstep, voffB);
        PG8_WAIT_V(6); PG8_BAR;
    }
    for (;;) {
        const bool has_next = S.next(ui + 1, nxt);
        const char* nA = has_next ? (const char*)g.A + (size_t)nxt.pm * tstep : cA; const char* nB = has_next ? (const char*)g.Bt + (size_t)nxt.pn * tstep : cB;
        for (int t = 0; t < nt; t += 2) {
            const bool last = (t == nt - 2);
            const char* a1 = cA + (size_t)(t + 1) * kstep;
            const char* a2 = last ? nA : cA + (size_t)(t + 2) * kstep; const char* b2 = last ? nB : cB + (size_t)(t + 2) * kstep;
            const char* a3 = a2 + kstep; const char* b3 = b2 + kstep;
            if (last && has_next) S.a_ready(nxt);
            if constexpr (SP2) {
            PG8_LDB(B0, 0, 0); PG8_LDB(B1, 0, 1); PG8_SCHED; PG8_LDA(At, 0, 0); PG8_STAGE(PG8_SA(1, 1), a1 + hstep, voffA);
            PG8_WAIT_V(8); PG8_WAIT_L(0); PG8_BAR; PG8_MMA(0, 0, At, B0); PG8_MMA(0, 1, At, B1); PG8_BAR; PG8_SCHED;
            PG8_LDA(At, 0, 1); PG8_STAGE(PG8_SB(0, 0), b2, voffB); PG8_STAGE(PG8_SB(0, 1), b2 + hstep, voffB); PG8_STAGE(PG8_SA(0, 0), a2, voffA);
            PG8_WAIT_V(8); PG8_WAIT_L(0); PG8_BAR; PG8_MMA(1, 0, At, B0); PG8_MMA(1, 1, At, B1); PG8_BAR; PG8_SCHED;
            PG8_LDB(B0, 1, 0); PG8_LDB(B1, 1, 1); PG8_SCHED; PG8_LDA(At, 1, 0); PG8_STAGE(PG8_SA(0, 1), a2 + hstep, voffA);
            PG8_WAIT_V(8); PG8_WAIT_L(0); PG8_BAR; PG8_MMA(0, 0, At, B0); PG8_MMA(0, 1, At, B1); PG8_BAR; PG8_SCHED;
            PG8_LDA(At, 1, 1); PG8_STAGE(PG8_SB(1, 0), b3, voffB); PG8_STAGE(PG8_SB(1, 1), b3 + hstep, voffB); PG8_STAGE(PG8_SA(1, 0), a3, voffA);
            PG8_WAIT_V(8); PG8_WAIT_L(0); PG8_BAR; PG8_MMA(1, 0, At, B0); PG8_MMA(1, 1, At, B1); PG8_BAR; PG8_SCHED;
            } else {
            PG8_LDB(B0, 0, 0); PG8_SCHED; PG8_LDA(At, 0, 0); PG8_STAGE(PG8_SA(1, 1), a1 + hstep, voffA);
            PG8_WAIT_L(8); PG8_BAR; PG8_WAIT_L(0); PG8_MMA(0, 0, At, B0); PG8_BAR; PG8_SCHED;
            PG8_LDB(B1, 0, 1); PG8_STAGE(PG8_SB(0, 0), b2, voffB);
            PG8_BAR; PG8_WAIT_L(0); PG8_MMA(0, 1, At, B1); PG8_BAR;
            PG8_LDA(At, 0, 1); PG8_STAGE(PG8_SA(0, 0), a2, voffA);
            PG8_BAR; PG8_WAIT_L(0); PG8_MMA(1, 0, At, B0); PG8_BAR; PG8_SCHED;
            PG8_STAGE(PG8_SB(0, 1), b2 + hstep, voffB);
            PG8_WAIT_V(6); PG8_BAR; PG8_MMA(1, 1, At, B1); PG8_BAR;
            PG8_LDB(B0, 1, 0); PG8_SCHED; PG8_LDA(At, 1, 0); PG8_STAGE(PG8_SA(0, 1), a2 + hstep, voffA);
            PG8_WAIT_L(8); PG8_BAR; PG8_WAIT_L(0); PG8_MMA(0, 0, At, B0); PG8_BAR; PG8_SCHED;
            PG8_LDB(B1, 1, 1); PG8_STAGE(PG8_SB(1, 0), b3, voffB);
            PG8_BAR; PG8_WAIT_L(0); PG8_MMA(0, 1, At, B1); PG8_BAR;
            PG8_LDA(At, 1, 1); PG8_STAGE(PG8_SA(1, 0), a3, voffA);
            PG8_BAR; PG8_WAIT_L(0); PG8_MMA(1, 0, At, B0); PG8_BAR; PG8_SCHED;
            PG8_STAGE(PG8_SB(1, 1), b3 + hstep, voffB);
            PG8_WAIT_V(6); PG8_BAR; PG8_MMA(1, 1, At, B1); PG8_BAR;
            }
        }
        if constexpr (ALIGN_EPI) { if (wr == 0) PG8_BAR; }
        if constexpr (!Epi::AFTER_DRAIN) { E(acc, cur, wr, wc, fr, fq); S.done(cur); }
        if (!has_next) break;
#pragma unroll
        for (int a = 0; a < 2; ++a)
#pragma unroll
            for (int b = 0; b < 2; ++b)
#pragma unroll
                for (int m = 0; m < 4; ++m)
#pragma unroll
                    for (int n = 0; n < 2; ++n) acc[a][b][m][n] = (f32x4){0.f, 0.f, 0.f, 0.f};
        cur = nxt; cA = nA; cB = nB; ++ui;
        if constexpr (ALIGN_EPI) { if (wr == 1) PG8_BAR; }
    }
    PG8_WAIT_V(0);
    if constexpr (!ALIGN_EPI) { if (wr == 0) PG8_BAR; }
    PG8_BAR;
    if constexpr (Epi::AFTER_DRAIN) { E.fused(acc, cur, wr, wc, fr, fq, lds, wid, lane); S.done(cur); }
#undef PG8_SA
#undef PG8_SB
#undef PG8_STAGE
#undef PG8_LDA
#undef PG8_LDB
#undef PG8_MMA
#undef PG8_WAIT_V
#undef PG8_WAIT_L
#undef PG8_BAR
#undef PG8_SCHED
}
}

#define DI __device__ __forceinline__
#define LAS __attribute__((address_space(3)))
typedef unsigned short bf16_t;
typedef short bf16x8 __attribute__((ext_vector_type(8)));
typedef float f32x4 __attribute__((ext_vector_type(4)));
typedef unsigned u32x4 __attribute__((ext_vector_type(4)));
typedef unsigned u32x2 __attribute__((ext_vector_type(2)));
using pg8::pk;
using pg8::sigm;

constexpr int DM = 1024, DEPTH = 4, SEQ_P = 16384, SEQ_S = 4096;
constexpr int MTOK = 81920, DIN = 6144, DFF = 4096, NWIN = 5120;
constexpr int NUNIT_R = 1280;
constexpr size_t MiB = 1u << 20;
constexpr size_t WS_BAR = 65536, WS_ROPE = 1 * MiB, WS_BTIN = 6 * MiB, WS_WVT = 16 * MiB, WS_BTO = 18 * MiB, WS_BT1 = 20 * MiB, WS_BT2 = 28 * MiB;
constexpr size_t WS_HM = 40 * MiB, WS_Q = 200 * MiB, WS_K = 280 * MiB, WS_VT = 360 * MiB, WS_G1 = 520 * MiB, WS_U = 680 * MiB, WS_SGP = 840 * MiB, WS_END = 1000 * MiB;
constexpr size_t WS_Y = WS_Q, WS_F = WS_VT, WS_ST = WS_HM;
constexpr int LDS_BYTES = 147456;
#ifndef PH
#define PH 255
#endif
#ifndef GEMM_REP
#define GEMM_REP 1
#endif
#ifndef R3_REP
#define R3_REP 1
#endif
#ifndef E_REP
#define E_REP 1
#endif
#ifndef SYNC_REP
#define SYNC_REP 1
#endif
constexpr int L_QS = 0, L_KS = 18432, L_VT = 36864, L_KT = 71680, L_FF = 89088, L_FB = 107520, L_OS = 0, L_US = 36864, L_KT2 = 89088;

__device__ const double ROPE_INV[32] = {1.0, 0.7498942093324559, 0.5623413251903491, 0.4216965034285822, 0.31622776601683794, 0.23713737056616552, 0.1778279410038923, 0.1333521432163324, 0.1, 0.07498942093324558, 0.05623413251903491, 0.042169650342858224, 0.03162277660168379, 0.023713737056616554, 0.01778279410038923, 0.01333521432163324, 0.01, 0.007498942093324558, 0.005623413251903491, 0.004216965034285823, 0.0031622776601683794, 0.0023713737056616554, 0.0017782794100389228, 0.001333521432163324, 0.001, 0.0007498942093324559, 0.0005623413251903491, 0.00042169650342858224, 0.00031622776601683794, 0.00023713737056616554, 0.00017782794100389227, 0.0001333521432163324};

struct Params { const float* in[15]; float* out; unsigned char* ws; };


typedef const __attribute__((address_space(4))) unsigned char* kargp_t;
DI kargp_t kargs() { kargp_t k = (kargp_t)__builtin_amdgcn_kernarg_segment_ptr(); asm volatile("" : "+s"(k)); return k; }
DI const float* arg_in(int i) { return *(const float* const __attribute__((address_space(4)))*)(kargs() + 8 * i); }
DI float* arg_out() { return *(float* const __attribute__((address_space(4)))*)(kargs() + 120); }
DI unsigned char* arg_ws() { return *(unsigned char* const __attribute__((address_space(4)))*)(kargs() + 128); }

DI float bflo(unsigned w) { return __uint_as_float(w << 16); }
DI float bfhi(unsigned w) { return __uint_as_float(w & 0xffff0000u); }
DI float ex2(float x) { return __builtin_amdgcn_exp2f(x); }
DI float wave_sum(float v) {
#pragma unroll
    for (int o = 1; o < 64; o <<= 1) v += __shfl_xor(v, o);
    return v;
}
DI f32x4 mfma16(bf16x8 x, bf16x8 y, f32x4 c) { return __builtin_amdgcn_mfma_f32_16x16x32_bf16(x, y, c, 0, 0, 0); }
DI bf16x8 as_bf(u32x4 v) { return __builtin_bit_cast(bf16x8, v); }
DI float log2_gamma(float x) { return -log1pf(__expf(-x)) * 1.4426950408889634f; }

DI void tr_item(const float* Wsrc, int ldw, int k0, bf16_t* dst, int Kd, const float* gain, float scale, LAS float* scr, int lane) {
#pragma unroll 8
    for (int i = 0; i < 32; ++i) { const int kk = 2 * i + (lane >> 5); float v = Wsrc[(size_t)(k0 + kk) * ldw + (lane & 31)] * scale; if (gain) v *= gain[k0 + kk]; scr[kk * 33 + (lane & 31)] = v; }
    asm volatile("s_waitcnt lgkmcnt(0)" ::: "memory");
    const int c = lane & 7;
#pragma unroll
    for (int j = 0; j < 4; ++j) { const int n = (lane >> 3) + 8 * j; const LAS float* s = scr + (8 * c) * 33 + n;
        u32x4 o; o.x = pk(s[0 * 33], s[1 * 33]); o.y = pk(s[2 * 33], s[3 * 33]); o.z = pk(s[4 * 33], s[5 * 33]); o.w = pk(s[6 * 33], s[7 * 33]);
        *(u32x4*)(dst + (size_t)n * Kd + k0 + 8 * c) = o; }
    asm volatile("s_waitcnt lgkmcnt(0)" ::: "memory");
}

DI void convert_layer(int l, LAS unsigned char* lds, int gw, int NGW, int wave, int lane) {
    unsigned char* ws = arg_ws();
    LAS float* scr = (LAS float*)(lds + wave * 16384);
    const float* win = arg_in(4) + (size_t)l * DM * DIN; const float* gpre = arg_in(2) + l * DM;
    const float* wout = arg_in(10) + (size_t)l * DM * DM; const float* gmlp = arg_in(11) + l * DM;
    const float* w1 = arg_in(13) + (size_t)l * DM * DFF; const float* w2 = arg_in(14) + (size_t)l * DFF * DM;
    const float* pw = arg_in(8) + (size_t)l * 4 * 256 * 256; const float* psc = arg_in(9) + l * DM;
    bf16_t* BTin = (bf16_t*)(ws + WS_BTIN); bf16_t* WvT = (bf16_t*)(ws + WS_WVT); bf16_t* BTo = (bf16_t*)(ws + WS_BTO);
    bf16_t* BT1 = (bf16_t*)(ws + WS_BT1); bf16_t* BT2 = (bf16_t*)(ws + WS_BT2);
    for (int it = gw; it < 9216; it += NGW) {
        if (it < 2048) {
            const int sg = it >> 4, kb = it & 15; const int slot0 = sg < 96 ? sg * 32 : 4096 + (sg - 96) * 32;
            const int pn = slot0 >> 8, t = slot0 & 255, bj = t >> 7, wcid = (t >> 5) & 3; int src; float sc = 1.f;
            if (pn < 2) src = ((pn & 1) * 4 + wcid) * 64 + 32 * bj;
            else if (pn < 4) { src = 512 + ((pn & 1) * 4 + wcid) * 64 + 32 * bj; sc = 0.125f; }
            else if (pn < 12) src = (bj ? 4096 : 2048) + 128 * (pn - 4) + 32 * wcid;
            else src = 5120 + (slot0 - 4096);
            tr_item(win + src, DIN, 64 * kb, BTin + (size_t)slot0 * DM, DM, gpre, sc, scr, lane);
        } else if (it < 2560) { const int r = it - 2048, nb = r >> 4, kb = r & 15; tr_item(win + 1024 + 32 * nb, DIN, 64 * kb, WvT + (size_t)(32 * nb) * DM, DM, gpre, 1.f, scr, lane);
        } else if (it < 3072) { const int r = it - 2560, nb = r >> 4, kb = r & 15; tr_item(wout + 32 * nb, DM, 64 * kb, BTo + (size_t)(32 * nb) * DM, DM, nullptr, 1.f, scr, lane);
        } else if (it < 5120) { const int r = it - 3072, nb = r >> 4, kb = r & 15; tr_item(w1 + 32 * nb, DFF, 64 * kb, BT1 + (size_t)(32 * nb) * DM, DM, gmlp, 1.f, scr, lane);
        } else if (it < 7168) { const int r = it - 5120, nb = r >> 6, kb = r & 63; tr_item(w2 + 32 * nb, DM, 64 * kb, BT2 + (size_t)(32 * nb) * DFF, DFF, nullptr, 1.f, scr, lane);
        } else {
            const int fi = it - 7168, ng = fi & 15, kg = fi >> 4; const int g = ng >> 2, d = (ng & 3) * 64 + lane, n = 256 * g + d, k0 = 8 * kg;
            const float* pwp = pw + (size_t)g * 65536 + d; const float* wp = win + (size_t)k0 * DIN + 3072 + g * 256;
            float a[8];
#pragma unroll
            for (int kk = 0; kk < 8; ++kk) a[kk] = 0.f;
            for (int c = 0; c < 256; c += 4) {
                const float p0 = pwp[(c + 0) * 256], p1 = pwp[(c + 1) * 256], p2 = pwp[(c + 2) * 256], p3 = pwp[(c + 3) * 256];
#pragma unroll
                for (int kk = 0; kk < 8; ++kk) { const f32x4 wv = *(const f32x4*)(wp + (size_t)kk * DIN + c); a[kk] += wv[0] * p0 + wv[1] * p1 + wv[2] * p2 + wv[3] * p3; }
            }
            const float sn = psc[n];
#pragma unroll
            for (int kk = 0; kk < 8; ++kk) a[kk] *= sn * gpre[k0 + kk];
            u32x4 o; o.x = pk(a[0], a[1]); o.y = pk(a[2], a[3]); o.z = pk(a[4], a[5]); o.w = pk(a[6], a[7]);
            *(u32x4*)(BTin + (size_t)(3072 + n) * DM + k0) = o;
        }
    }
}

DI void e0_phase(const float* xa, const float* xb, bf16_t* H, int gw, int NGW, int lane) {
    for (int m = gw; m < MTOK; m += NGW) {
        const float* xr = m < SEQ_P ? xa + (size_t)m * DM : xb + (size_t)(m - SEQ_P) * DM;
        f32x4 xv[4]; float ss = 0.f;
#pragma unroll
        for (int j = 0; j < 4; ++j) { xv[j] = *(const f32x4*)(xr + 4 * lane + 256 * j); ss += xv[j][0] * xv[j][0] + xv[j][1] * xv[j][1] + xv[j][2] * xv[j][2] + xv[j][3] * xv[j][3]; }
        const float r = rsqrtf(wave_sum(ss) * (1.f / DM) + 1e-6f);
#pragma unroll
        for (int j = 0; j < 4; ++j) { u32x2 o; o.x = pk(xv[j][0] * r, xv[j][1] * r); o.y = pk(xv[j][2] * r, xv[j][3] * r); *(u32x2*)(H + (size_t)m * DM + 4 * lane + 256 * j) = o; }
    }
}
DI void e_phase(const bf16_t* Y, const float* xa, const float* xb, const float* gpost, float* out, bf16_t* H, int gw, int NGW, int lane, int do_store) {
    f32x4 g[4];
#pragma unroll
    for (int j = 0; j < 4; ++j) g[j] = *(const f32x4*)(gpost + 4 * lane + 256 * j);
    for (int m = gw; m < MTOK; m += NGW) {
        const float* xr = m < SEQ_P ? xa + (size_t)m * DM : xb + (size_t)(m - SEQ_P) * DM;
        f32x4 xv[4], yv[4]; float ss = 0.f;
#pragma unroll
        for (int j = 0; j < 4; ++j) { const u32x2 yb = *(const u32x2*)(Y + (size_t)m * DM + 4 * lane + 256 * j); xv[j] = *(const f32x4*)(xr + 4 * lane + 256 * j);
            yv[j] = (f32x4){bflo(yb.x), bfhi(yb.x), bflo(yb.y), bfhi(yb.y)}; ss += yv[j][0] * yv[j][0] + yv[j][1] * yv[j][1] + yv[j][2] * yv[j][2] + yv[j][3] * yv[j][3]; }
        const float ry = rsqrtf(wave_sum(ss) * (1.f / DM) + 1e-6f); float s1 = 0.f;
#pragma unroll
        for (int j = 0; j < 4; ++j) { xv[j] = xv[j] + yv[j] * ry * g[j]; s1 += xv[j][0] * xv[j][0] + xv[j][1] * xv[j][1] + xv[j][2] * xv[j][2] + xv[j][3] * xv[j][3]; }
#pragma unroll
        for (int j = 0; j < 4; ++j) if (do_store) *(f32x4*)(out + (size_t)m * DM + 4 * lane + 256 * j) = xv[j];
        if (H) {
            const float r1 = rsqrtf(wave_sum(s1) * (1.f / DM) + 1e-6f);
#pragma unroll
            for (int j = 0; j < 4; ++j) { u32x2 o; o.x = pk(xv[j][0] * r1, xv[j][1] * r1); o.y = pk(xv[j][2] * r1, xv[j][3] * r1); if (do_store) *(u32x2*)(H + (size_t)m * DM + 4 * lane + 256 * j) = o; }
        }
    }
}

DI void state_mma(f32x4 (&acc)[4], LAS unsigned char* Kt, LAS unsigned char* Vt, int w, int r, int q) {
#pragma unroll
    for (int s4 = 0; s4 < 4; ++s4) {
        const bf16x8 vy = *(const LAS bf16x8*)(Vt + (16 * w + r) * 272 + (32 * s4 + 8 * q) * 2);
#pragma unroll
        for (int dt = 0; dt < 4; ++dt) { const bf16x8 kx = *(const LAS bf16x8*)(Kt + (16 * dt + r) * 272 + (32 * s4 + 8 * q) * 2); acc[dt] = mfma16(kx, vy, acc[dt]); }
    }
}
DI void write_kt(LAS unsigned char* Kt, const u32x4 ka, const u32x4 kb, float za, float zb, int w, int lane) {
#pragma unroll
    for (int e = 0; e < 8; ++e) { const unsigned wa = ka[e >> 1], wb = kb[e >> 1]; const float a = (e & 1) ? bfhi(wa) : bflo(wa), b = (e & 1) ? bfhi(wb) : bflo(wb);
        *(LAS unsigned*)(Kt + (8 * w + e) * 272 + lane * 4) = pk(a * za, b * zb); }
}
DI void load_k(const bf16_t* Kb, int row0, int h, int w, int lane, u32x4& ka, u32x4& kb) {
    const bf16_t* pk0 = Kb + (size_t)(row0 + 2 * lane) * 512 + h * 64 + 8 * w; ka = *(const u32x4*)pk0; kb = *(const u32x4*)(pk0 + 512);
}
DI void load_vt(const bf16_t* VT, int row0, int h, int tid, u32x4 (&vv)[4]) {
#pragma unroll
    for (int it = 0; it < 4; ++it) { const int item = tid + 512 * it, dv = item >> 4, tg = item & 15; vv[it] = *(const u32x4*)(VT + (size_t)(h * 128 + dv) * MTOK + row0 + 8 * tg); }
}
DI void write_vt(LAS unsigned char* Vt, int tid, const u32x4 (&vv)[4]) {
#pragma unroll
    for (int it = 0; it < 4; ++it) { const int item = tid + 512 * it, dv = item >> 4, tg = item & 15; *(LAS u32x4*)(Vt + dv * 272 + tg * 16) = vv[it]; }
}

DI void r1_phase(LAS unsigned char* lds, const bf16_t* Kb, const bf16_t* VT, f32x4* ST, const float* decf, const float* decb, int G, int bid, int tid) {
    const int lane = tid & 63, w = __builtin_amdgcn_readfirstlane(tid >> 6), r = lane & 15, q = lane >> 4;
    LAS unsigned char* Vt = lds + L_VT; LAS unsigned char* Ktf = lds + L_KT; LAS unsigned char* Ktb = lds + L_KT2;
    for (int u = bid; u < NUNIT_R; u += G) {
        const int seg = u >> 3, h = u & 7;
        const float lf2 = log2_gamma(decf[h]), lb2 = log2_gamma(decb[h]);
        f32x4 accF[4], accB[4];
#pragma unroll
        for (int dt = 0; dt < 4; ++dt) { accF[dt] = (f32x4){0.f, 0.f, 0.f, 0.f}; accB[dt] = (f32x4){0.f, 0.f, 0.f, 0.f}; }
#pragma unroll 1
        for (int c = 0; c < 4; ++c) {
            const int row0 = seg * 512 + c * 128; u32x4 ka, kb, vv[4];
            load_k(Kb, row0, h, w, lane, ka, kb); load_vt(VT, row0, h, tid, vv);
            const float tl = (float)(c * 128 + 2 * lane);
            const float zf0 = ex2((511.f - tl) * lf2), zf1 = ex2((510.f - tl) * lf2), zb0 = ex2(tl * lb2), zb1 = ex2((tl + 1.f) * lb2);
            __syncthreads();
            write_kt(Ktf, ka, kb, zf0, zf1, w, lane); write_kt(Ktb, ka, kb, zb0, zb1, w, lane); write_vt(Vt, tid, vv);
            __syncthreads();
            state_mma(accF, Ktf, Vt, w, r, q); state_mma(accB, Ktb, Vt, w, r, q);
        }
#pragma unroll
        for (int dt = 0; dt < 4; ++dt) { ST[((size_t)u * 2 + 0) * 2048 + tid * 4 + dt] = accF[dt]; ST[((size_t)u * 2 + 1) * 2048 + tid * 4 + dt] = accB[dt]; }
    }
}

#define R3_IDS int tid = tid0; asm volatile("" : "+v"(tid)); const int lane = tid & 63, r = lane & 15, q = lane >> 4; (void)r; (void)q; (void)lane;
DI void r3_phase(LAS unsigned char* lds, const bf16_t* Qb, const bf16_t* Kb, const bf16_t* VT, bf16_t* G1, const bf16_t* U, const bf16_t* SGP, const f32x4* ST, u32x4* BSV,
                 const float* decf, const float* decb, const float* gn, int G, int bid, int tid0, int do_store) {
    const int w = __builtin_amdgcn_readfirstlane(tid0 >> 6);
    LAS unsigned char* Qs = lds + L_QS; LAS unsigned char* Ks = lds + L_KS; LAS unsigned char* Vt = lds + L_VT; LAS unsigned char* Kt = lds + L_KT;
    LAS unsigned char* Ff = lds + L_FF; LAS unsigned char* Fb = lds + L_FB; LAS unsigned char* Os = lds + L_OS; LAS unsigned char* Us = lds + L_US;
#pragma unroll 1
    for (int u = bid; u < NUNIT_R; u += G) {
        const int seg = u >> 3, h = u & 7;
        const int s_lo = seg < 32 ? 0 : 32 + ((seg - 32) & ~7), s_hi = seg < 32 ? 32 : s_lo + 8;
        const int seqlo = s_lo * 512, seqhi = s_hi * 512;
        const float lf2 = log2_gamma(decf[h]), lb2 = log2_gamma(decb[h]);
        const float cdf = ex2(128.f * lf2), cdb = ex2(128.f * lb2);
        f32x4 accF[4], accB[4];
#pragma unroll
        for (int dt = 0; dt < 4; ++dt) { accF[dt] = (f32x4){0.f, 0.f, 0.f, 0.f}; accB[dt] = (f32x4){0.f, 0.f, 0.f, 0.f}; }
        { R3_IDS
          const float sf = ex2(512.f * lf2); float fac = 1.f;
#pragma unroll 1
          for (int s2 = seg - 1; s2 >= s_lo && fac > 1e-25f; --s2) { const f32x4* sp = ST + ((size_t)(s2 * 8 + h) * 2 + 0) * 2048 + tid * 4;
#pragma unroll
              for (int dt = 0; dt < 4; ++dt) accF[dt] += sp[dt] * fac;
              fac *= sf; }
          const float sb = ex2(512.f * lb2); fac = 1.f;
#pragma unroll 1
          for (int s2 = seg + 1; s2 < s_hi && fac > 1e-25f; ++s2) { const f32x4* sp = ST + ((size_t)(s2 * 8 + h) * 2 + 1) * 2048 + tid * 4;
#pragma unroll
              for (int dt = 0; dt < 4; ++dt) accB[dt] += sp[dt] * fac;
              fac *= sb; } }
#pragma unroll 1
        for (int c = 3; c >= 0; --c) {
            R3_IDS
            { u32x4 p0, p1; p0.x = pk(accB[0][0], accB[0][1]); p0.y = pk(accB[0][2], accB[0][3]); p0.z = pk(accB[1][0], accB[1][1]); p0.w = pk(accB[1][2], accB[1][3]);
              p1.x = pk(accB[2][0], accB[2][1]); p1.y = pk(accB[2][2], accB[2][3]); p1.z = pk(accB[3][0], accB[3][1]); p1.w = pk(accB[3][2], accB[3][3]);
              BSV[(c * 512 + tid) * 2] = p0; BSV[(c * 512 + tid) * 2 + 1] = p1; }
            if (c == 0) break;
            const int row0 = seg * 512 + c * 128; u32x4 ka, kb, vv[4];
            load_k(Kb, row0, h, w, lane, ka, kb); load_vt(VT, row0, h, tid, vv);
            const float tj = (float)(2 * lane); const float zb0 = ex2(tj * lb2), zb1 = ex2((tj + 1.f) * lb2);
            __syncthreads();
            write_kt(Kt, ka, kb, zb0, zb1, w, lane); write_vt(Vt, tid, vv);
            __syncthreads();
#pragma unroll
            for (int dt = 0; dt < 4; ++dt) accB[dt] *= cdb;
            state_mma(accB, Kt, Vt, w, r, q);
        }
        const int half = 1 << (h >> 1);
#pragma unroll 1
        for (int c = 0; c < 4; ++c) {
            const int row0 = seg * 512 + c * 128;
            { R3_IDS
              u32x4 ka, kb, vv[4], qv[2];
              load_k(Kb, row0, h, w, lane, ka, kb); load_vt(VT, row0, h, tid, vv);
#pragma unroll
              for (int it = 0; it < 2; ++it) { const int item = tid + 512 * it, tok = item >> 3, g8 = item & 7; qv[it] = *(const u32x4*)(Qb + (size_t)(row0 + tok) * 512 + h * 64 + 8 * g8); }
              const float tj = (float)(2 * lane); const float zf0 = ex2((127.f - tj) * lf2), zf1 = ex2((126.f - tj) * lf2);
              const u32x4 bs0 = BSV[(c * 512 + tid) * 2], bs1 = BSV[(c * 512 + tid) * 2 + 1];
              __syncthreads();
              write_kt(Kt, ka, kb, zf0, zf1, w, lane); write_vt(Vt, tid, vv);
              *(LAS u32x4*)(Ks + (2 * lane) * 144 + 16 * w) = ka; *(LAS u32x4*)(Ks + (2 * lane + 1) * 144 + 16 * w) = kb;
#pragma unroll
              for (int it = 0; it < 2; ++it) { const int item = tid + 512 * it, tok = item >> 3, g8 = item & 7; *(LAS u32x4*)(Qs + tok * 144 + 16 * g8) = qv[it]; }
#pragma unroll
              for (int dt = 0; dt < 4; ++dt) {
                u32x2 ff; ff.x = pk(accF[dt][0], accF[dt][1]); ff.y = pk(accF[dt][2], accF[dt][3]);
                *(LAS u32x2*)(Ff + (16 * w + r) * 144 + (16 * dt + 4 * q) * 2) = ff;
                u32x2 fb; fb.x = dt < 2 ? bs0[2 * dt] : bs1[2 * dt - 4]; fb.y = dt < 2 ? bs0[2 * dt + 1] : bs1[2 * dt - 3];
                *(LAS u32x2*)(Fb + (16 * w + r) * 144 + (16 * dt + 4 * q) * 2) = fb; }
              __syncthreads(); }
            f32x4 ao[8]; float rs;
            { R3_IDS
              u32x4 qf[2];
#pragma unroll
              for (int s = 0; s < 2; ++s) qf[s] = *(const LAS u32x4*)(Qs + (16 * w + r) * 144 + (32 * s + 8 * q) * 2);
              f32x4 as[8];
#pragma unroll
              for (int jt = 0; jt < 8; ++jt) { as[jt] = (f32x4){0.f, 0.f, 0.f, 0.f};
#pragma unroll
                for (int s = 0; s < 2; ++s) { const bf16x8 kx = *(const LAS bf16x8*)(Ks + (16 * jt + r) * 144 + (32 * s + 8 * q) * 2); as[jt] = mfma16(kx, as_bf(qf[s]), as[jt]); } }
              const int i = 16 * w + r;
#pragma unroll
              for (int jt = 0; jt < 8; ++jt)
#pragma unroll
                for (int jj = 0; jj < 4; ++jj) { const int d = i - (16 * jt + 4 * q + jj); const float fd = (float)d; as[jt][jj] *= ex2(d >= 0 ? fd * lf2 : -fd * lb2); }
              u32x4 pf[4];
#pragma unroll
              for (int s2 = 0; s2 < 4; ++s2) { pf[s2].x = pk(as[2 * s2][0], as[2 * s2][1]); pf[s2].y = pk(as[2 * s2][2], as[2 * s2][3]); pf[s2].z = pk(as[2 * s2 + 1][0], as[2 * s2 + 1][1]); pf[s2].w = pk(as[2 * s2 + 1][2], as[2 * s2 + 1][3]); }
              const float xf = ex2((float)(i + 1) * lf2), xb = ex2((float)(128 - i) * lb2);
              u32x4 qff[2], qbb[2];
#pragma unroll
              for (int s = 0; s < 2; ++s)
#pragma unroll
                for (int k = 0; k < 4; ++k) { const float lo = bflo(qf[s][k]), hi = bfhi(qf[s][k]); qff[s][k] = pk(lo * xf, hi * xf); qbb[s][k] = pk(lo * xb, hi * xb); }
              __builtin_amdgcn_sched_barrier(0);
#pragma unroll
              for (int t = 0; t < 8; ++t) { ao[t] = (f32x4){0.f, 0.f, 0.f, 0.f};
#pragma unroll
                for (int s2 = 0; s2 < 4; ++s2) { const u32x2 lo = *(const LAS u32x2*)(Vt + (16 * t + r) * 272 + (32 * s2 + 4 * q) * 2), hi = *(const LAS u32x2*)(Vt + (16 * t + r) * 272 + (32 * s2 + 16 + 4 * q) * 2);
                    const u32x4 vx = {lo.x, lo.y, hi.x, hi.y}; ao[t] = mfma16(as_bf(vx), as_bf(pf[s2]), ao[t]); }
#pragma unroll
                for (int s = 0; s < 2; ++s) { const bf16x8 fx = *(const LAS bf16x8*)(Ff + (16 * t + r) * 144 + (32 * s + 8 * q) * 2); ao[t] = mfma16(fx, as_bf(qff[s]), ao[t]);
                    const bf16x8 bx = *(const LAS bf16x8*)(Fb + (16 * t + r) * 144 + (32 * s + 8 * q) * 2); ao[t] = mfma16(bx, as_bf(qbb[s]), ao[t]); }
                if (t & 1) __builtin_amdgcn_sched_barrier(0); }
              if (c < 3) {
#pragma unroll
                for (int dt = 0; dt < 4; ++dt) accF[dt] *= cdf;
                state_mma(accF, Kt, Vt, w, r, q); }
              __builtin_amdgcn_sched_barrier(0);
              float s1 = 0.f;
#pragma unroll
              for (int t = 0; t < 8; ++t) s1 += (ao[t][0] + ao[t][1]) + (ao[t][2] + ao[t][3]);
              s1 += __shfl_xor(s1, 16); s1 += __shfl_xor(s1, 32);
              const float mu = s1 * (1.f / 128.f); float s2v = 0.f;
#pragma unroll
              for (int t = 0; t < 8; ++t) { ao[t] = ao[t] - mu; s2v += (ao[t][0] * ao[t][0] + ao[t][1] * ao[t][1]) + (ao[t][2] * ao[t][2] + ao[t][3] * ao[t][3]); }
              s2v += __shfl_xor(s2v, 16); s2v += __shfl_xor(s2v, 32);
              rs = rsqrtf(s2v * (1.f / 128.f) + 1e-6f);
              __syncthreads(); }
            { R3_IDS
#pragma unroll
              for (int t = 0; t < 8; ++t) { u32x2 o; o.x = pk(ao[t][0] * rs, ao[t][1] * rs); o.y = pk(ao[t][2] * rs, ao[t][3] * rs); *(LAS u32x2*)(Os + (16 * w + r) * 272 + (16 * t + 4 * q) * 2) = o; }
#pragma unroll
              for (int it = 0; it < 5; ++it) { const int item = tid + 512 * it, rr = item >> 4, cgp = item & 15, grow = row0 - 8 + rr;
                if (item < 2304 && grow >= seqlo && grow < seqhi) *(LAS u32x4*)(Us + rr * 272 + cgp * 16) = *(const u32x4*)(U + (size_t)grow * DM + h * 128 + 8 * cgp); }
              __syncthreads(); }
#pragma unroll 1
            for (int it = 0; it < 4; ++it) {
                R3_IDS
                const int item = tid + 512 * it, tok = item >> 4, cgp = item & 15, grow = row0 + tok;
                const size_t goff = (size_t)grow * DM + h * 128 + 8 * cgp;
                const u32x4 g1 = *(const u32x4*)(G1 + goff), sg = *(const u32x4*)(SGP + goff);
                const f32x4 ga = *(const f32x4*)(gn + h * 128 + 8 * cgp), gb = *(const f32x4*)(gn + h * 128 + 8 * cgp + 4);
                const u32x4 on = *(const LAS u32x4*)(Os + tok * 272 + cgp * 16);
                const int lo = max(grow - half, seqlo), hi = min(grow + half, seqhi);
                float a8[8];
#pragma unroll
                for (int k = 0; k < 8; ++k) a8[k] = 0.f;
#pragma unroll 1
                for (int t = lo; t < hi; ++t) { const u32x4 uw = *(const LAS u32x4*)(Us + (t - row0 + 8) * 272 + cgp * 16);
#pragma unroll
                    for (int k = 0; k < 4; ++k) { a8[2 * k] += bflo(uw[k]); a8[2 * k + 1] += bfhi(uw[k]); } }
                const u32x4 own = *(const LAS u32x4*)(Us + (tok + 8) * 272 + cgp * 16);
                const float inv = 1.f / (float)(hi - lo);
                float mo[8];
#pragma unroll
                for (int k = 0; k < 4; ++k) {
                    const float gl = k < 2 ? ga[2 * k] : gb[2 * k - 4], gh = k < 2 ? ga[2 * k + 1] : gb[2 * k - 3];
                    mo[2 * k] = bflo(g1[k]) * bflo(on[k]) * gl + bflo(sg[k]) * (a8[2 * k] * inv - bflo(own[k]));
                    mo[2 * k + 1] = bfhi(g1[k]) * bfhi(on[k]) * gh + bfhi(sg[k]) * (a8[2 * k + 1] * inv - bfhi(own[k])); }
                u32x4 o; o.x = pk(mo[0], mo[1]); o.y = pk(mo[2], mo[3]); o.z = pk(mo[4], mo[5]); o.w = pk(mo[6], mo[7]);
                if (do_store) *(u32x4*)(G1 + goff) = o;
            }
        }
    }
}

#define XB_TMO      128
#define XB_XCNT(j)  (256  + 64 * (j))
#define XB_XSUB(j)  (1280 + 64 * (j))
#define XB_XGEN(j)  (2304 + 64 * (j))
#define XB_TOP      3328
#define XB_TOPGEN   3392
#define XCD_BAR_WORDS 3456
#define XB_SPIN_CAP (1u << 18)

__device__ __forceinline__ unsigned xb_ld(unsigned* p)              { return __hip_atomic_load(p, __ATOMIC_RELAXED, __HIP_MEMORY_SCOPE_AGENT); }
__device__ __forceinline__ unsigned xb_add(unsigned* p, unsigned v) { return __hip_atomic_fetch_add(p, v, __ATOMIC_RELAXED, __HIP_MEMORY_SCOPE_AGENT); }
__device__ __forceinline__ unsigned xb_xcc_id() { return (unsigned)__builtin_amdgcn_s_getreg((3 << 11) | 20) & 0xFu; }
#define XB_SPIN(cond, bar) do { unsigned _sp = 0; while (cond) { __builtin_amdgcn_s_sleep(1); \
    if ((++_sp & 255u) == 0u) { if (xb_ld(&(bar)[XB_TMO])) break; if (_sp > XB_SPIN_CAP) { atomicAdd(&(bar)[XB_TMO], 1u); break; } } } } while (0)

struct XcdBarrier {
    unsigned* bar; unsigned x;
    volatile LAS unsigned* st;
};

__device__ __forceinline__ XcdBarrier xcd_barrier_post(unsigned* bar, volatile LAS unsigned* st) {
    XcdBarrier b; b.bar = bar; b.x = xb_xcc_id(); b.st = st;
    if (threadIdx.x == 0) (void)xb_add(&bar[XB_XCNT(b.x)], 1u);
    return b;
}
__device__ __forceinline__ void xcd_barrier_complete(unsigned* bar, unsigned x, unsigned& nloc, unsigned& nx) {
    const unsigned G = gridDim.x * gridDim.y * gridDim.z;
    unsigned sum, cnt, mine, sp = 0u;
    for (;;) {
        sum = 0u; cnt = 0u; mine = 0u;
#pragma unroll
        for (unsigned j = 0; j < 16; ++j) { const unsigned c = xb_ld(&bar[XB_XCNT(j)]); sum += c; cnt += (c > 0u) ? 1u : 0u; mine = (j == x) ? c : mine; }
        if (sum == G) break;
        __builtin_amdgcn_s_sleep(1);
        if ((++sp & 255u) == 0u) { if (xb_ld(&bar[XB_TMO])) break; if (sp > XB_SPIN_CAP) { atomicAdd(&bar[XB_TMO], 1u); break; } }
    }
    nloc = mine > 0u ? mine : 1u; nx = cnt > 0u ? cnt : 1u;
}

__device__ __forceinline__ void xcd_barrier(const XcdBarrier& b) {
    asm volatile("s_waitcnt vmcnt(0)" ::: "memory");
    __syncthreads();
    if (threadIdx.x == 0) {
        unsigned* bar = b.bar;
        __builtin_amdgcn_s_waitcnt(0);
        unsigned nloc = b.st[0], nx = b.st[1];
        if (nloc == 0u) { xcd_barrier_complete(bar, b.x, nloc, nx); b.st[0] = nloc; b.st[1] = nx; }
        const unsigned old = xb_add(&bar[XB_XSUB(b.x)], 1u);
        const unsigned gen = old / nloc;
        if (old + 1u == (gen + 1u) * nloc) {
            __builtin_amdgcn_fence(__ATOMIC_RELEASE, "agent");
            asm volatile("s_waitcnt vmcnt(0)" ::: "memory");
            const unsigned og = xb_add(&bar[XB_TOP], 1u);
            const unsigned tg = og / nx;
            if (og + 1u == (tg + 1u) * nx) xb_add(&bar[XB_TOPGEN], 1u);
            else XB_SPIN(xb_ld(&bar[XB_TOPGEN]) == tg, bar);
            __builtin_amdgcn_fence(__ATOMIC_ACQUIRE, "agent");
            xb_add(&bar[XB_XGEN(b.x)], 1u);
            asm volatile("s_waitcnt vmcnt(0)" ::: "memory");
        } else {
            XB_SPIN(xb_ld(&bar[XB_XGEN(b.x)]) == gen, bar);
            __builtin_amdgcn_fence(__ATOMIC_ACQUIRE, "agent");
            asm volatile("s_waitcnt vmcnt(0)" ::: "memory");
        }
    }
    __syncthreads();
}

__global__ void __launch_bounds__(512, 2) fwd_megakernel(Params p) {
    extern __shared__ __attribute__((aligned(16))) unsigned char lds_raw[];
    LAS unsigned char* lds = (LAS unsigned char*)lds_raw;
    cg::grid_group grid = cg::this_grid();
    volatile LAS unsigned* bst = (volatile LAS unsigned*)(lds + 139264);
    if (threadIdx.x < 2) bst[threadIdx.x] = 0u;
    __syncthreads();
    (void)xcd_barrier_post((unsigned*)(arg_ws() + WS_BAR), bst);
#define GRID_BAR() do { XcdBarrier b_; b_.bar = (unsigned*)(arg_ws() + WS_BAR); b_.x = xb_xcc_id(); b_.st = bst; xcd_barrier(b_); } while (0)
#define FRESH_IDS int tid = threadIdx.x; asm volatile("" : "+v"(tid)); const int lane = tid & 63, wave = __builtin_amdgcn_readfirstlane(tid >> 6); const int G = gridDim.x, bid = blockIdx.x, gw = bid * 8 + wave, NGW = G * 8; (void)lane; (void)gw; (void)NGW;
#define WSB(T, off) ((T*)(arg_ws() + (off)))

    { FRESH_IDS float* rope = WSB(float, WS_ROPE);
      for (int e = bid * 512 + tid; e < SEQ_P * 32; e += G * 512) {
        const int pos = e >> 5, i = e & 31; double rev = (double)pos * ROPE_INV[i] * 0.15915494309189535; rev -= floor(rev); const float rf = (float)rev;
        rope[pos * 64 + i] = __builtin_amdgcn_cosf(rf); rope[pos * 64 + 32 + i] = __builtin_amdgcn_sinf(rf); } }
#if PH & 1
    { FRESH_IDS convert_layer(0, lds, gw, NGW, wave, lane); }
#endif
    { FRESH_IDS e0_phase(arg_in(0), arg_in(1), WSB(bf16_t, WS_HM), gw, NGW, lane); }
    grid.sync();

#pragma unroll 1
    for (int l = 0; l < DEPTH; ++l) {
#if PH & 2
        _Pragma("unroll 1") for (int rep = 0; rep < GEMM_REP; ++rep)
        { FRESH_IDS unsigned char* ws = arg_ws();
          pg8::Gemm g{(bf16_t*)(ws + WS_HM), (bf16_t*)(ws + WS_BTIN), MTOK, NWIN, DM}; pg8::StaticOrder S; S.init(MTOK, NWIN, G, bid);
          pg8::EpiWin E{(bf16_t*)(ws + WS_Q), (bf16_t*)(ws + WS_K), (bf16_t*)(ws + WS_G1), (bf16_t*)(ws + WS_U), (bf16_t*)(ws + WS_SGP), (const float*)(ws + WS_ROPE)};
          pg8::gemm_phase<pg8::EpiWin, pg8::StaticOrder, true, true>(lds, g, S, E); }
#endif
#if PH & 4
        _Pragma("unroll 1") for (int rep = 0; rep < GEMM_REP; ++rep)
        { FRESH_IDS unsigned char* ws = arg_ws();
          pg8::Gemm g{(bf16_t*)(ws + WS_WVT), (bf16_t*)(ws + WS_HM), DM, MTOK, DM}; pg8::StaticOrder S; S.init(DM, MTOK, G, bid);
          pg8::EpiBf<0> E{(bf16_t*)(ws + WS_VT), (size_t)MTOK};
          pg8::gemm_phase<pg8::EpiBf<0>, pg8::StaticOrder, true, true>(lds, g, S, E); }
#endif
        _Pragma("unroll 1") for (int rep = 0; rep < SYNC_REP; ++rep) GRID_BAR();
#if PH & 8
        { FRESH_IDS unsigned char* ws = arg_ws();
          r1_phase(lds, (const bf16_t*)(ws + WS_K), (const bf16_t*)(ws + WS_VT), (f32x4*)(ws + WS_ST), arg_in(5) + l * 8, arg_in(6) + l * 8, G, bid, tid); }
#endif
        _Pragma("unroll 1") for (int rep = 0; rep < SYNC_REP; ++rep) GRID_BAR();
#if PH & 16
        _Pragma("unroll 1") for (int rep = 0; rep < R3_REP; ++rep)
        { FRESH_IDS unsigned char* ws = arg_ws(); int ds = (rep == R3_REP - 1); asm volatile("" : "+s"(ds));
          r3_phase(lds, (const bf16_t*)(ws + WS_Q), (const bf16_t*)(ws + WS_K), (const bf16_t*)(ws + WS_VT), (bf16_t*)(ws + WS_G1), (const bf16_t*)(ws + WS_U), (const bf16_t*)(ws + WS_SGP),
                   (const f32x4*)(ws + WS_ST), (u32x4*)(ws + WS_ST + 96 * MiB) + (size_t)bid * 4096, arg_in(5) + l * 8, arg_in(6) + l * 8, arg_in(7) + l * DM, G, bid, tid, ds); }
#endif
        _Pragma("unroll 1") for (int rep = 0; rep < SYNC_REP; ++rep) GRID_BAR();
#if PH & 32
        _Pragma("unroll 1") for (int rep = 0; rep < GEMM_REP; ++rep)
        { FRESH_IDS unsigned char* ws = arg_ws();
          pg8::Gemm g{(bf16_t*)(ws + WS_G1), (bf16_t*)(ws + WS_BTO), MTOK, DM, DM}; pg8::StaticOrder S; S.init(MTOK, DM, G, bid);
          pg8::EpiBf<0> E{(bf16_t*)(ws + WS_Y), (size_t)DM};
          pg8::gemm_phase<pg8::EpiBf<0>, pg8::StaticOrder, true, true>(lds, g, S, E); }
#endif
        _Pragma("unroll 1") for (int rep = 0; rep < SYNC_REP; ++rep) GRID_BAR();
        _Pragma("unroll 1") for (int rep = 0; rep < E_REP; ++rep)
        { FRESH_IDS float* out = arg_out(); int ds = (rep == E_REP - 1); asm volatile("" : "+s"(ds));
          e_phase(WSB(bf16_t, WS_Y), l == 0 ? arg_in(0) : out, l == 0 ? arg_in(1) : out + (size_t)SEQ_P * DM, arg_in(3) + l * DM, out, WSB(bf16_t, WS_HM), gw, NGW, lane, ds); }
        _Pragma("unroll 1") for (int rep = 0; rep < SYNC_REP; ++rep) GRID_BAR();
#if PH & 64
        _Pragma("unroll 1") for (int rep = 0; rep < GEMM_REP; ++rep)
        { FRESH_IDS unsigned char* ws = arg_ws();
          pg8::Gemm g{(bf16_t*)(ws + WS_HM), (bf16_t*)(ws + WS_BT1), MTOK, DFF, DM}; pg8::StaticOrder S; S.init(MTOK, DFF, G, bid);
          pg8::EpiBf<1> E{(bf16_t*)(ws + WS_F), (size_t)DFF};
          pg8::gemm_phase<pg8::EpiBf<1>, pg8::StaticOrder, true, true>(lds, g, S, E); }
#endif
        _Pragma("unroll 1") for (int rep = 0; rep < SYNC_REP; ++rep) GRID_BAR();
#if PH & 128
        _Pragma("unroll 1") for (int rep = 0; rep < GEMM_REP; ++rep)
        { FRESH_IDS unsigned char* ws = arg_ws();
          pg8::Gemm g{(bf16_t*)(ws + WS_F), (bf16_t*)(ws + WS_BT2), MTOK, DM, DFF}; pg8::StaticOrder S; S.init(MTOK, DM, G, bid);
          pg8::EpiBf<0> E{(bf16_t*)(ws + WS_Y), (size_t)DM};
          pg8::gemm_phase<pg8::EpiBf<0>, pg8::StaticOrder, true, true>(lds, g, S, E); }
#endif
        _Pragma("unroll 1") for (int rep = 0; rep < SYNC_REP; ++rep) GRID_BAR();
        _Pragma("unroll 1") for (int rep = 0; rep < E_REP; ++rep)
        { FRESH_IDS float* out = arg_out(); int ds = (rep == E_REP - 1); asm volatile("" : "+s"(ds));
          e_phase(WSB(bf16_t, WS_Y), out, out + (size_t)SEQ_P * DM, arg_in(12) + l * DM, out, l + 1 < DEPTH ? WSB(bf16_t, WS_HM) : nullptr, gw, NGW, lane, ds); }
        if (l + 1 < DEPTH) {
#if PH & 1
            { FRESH_IDS convert_layer(l + 1, lds, gw, NGW, wave, lane); }
#endif
            GRID_BAR(); }
    }
}

extern "C" void kernel_launch(void* const* d_in, const int* in_sizes, int n_in, void* d_out, int out_size, void* d_ws, size_t ws_size, hipStream_t stream) {
    static int grid = 0;
    if (grid == 0) {
        if (n_in != 15 || out_size != MTOK * DM || ws_size < WS_END) { fprintf(stderr, "kernel_launch: unexpected shapes (n_in %d, out %d, ws %zu)\n", n_in, out_size, ws_size); grid = -1; return; }
        int dev = 0, cus = 0, per_cu = 0;
        hipGetDevice(&dev); hipDeviceGetAttribute(&cus, hipDeviceAttributeMultiprocessorCount, dev);
        if (hipFuncSetAttribute((const void*)fwd_megakernel, hipFuncAttributeMaxDynamicSharedMemorySize, LDS_BYTES) != hipSuccess) { fprintf(stderr, "kernel_launch: hipFuncSetAttribute failed\n"); grid = -1; return; }
        if (hipOccupancyMaxActiveBlocksPerMultiprocessor(&per_cu, (const void*)fwd_megakernel, 512, LDS_BYTES) != hipSuccess || per_cu < 1) { fprintf(stderr, "kernel_launch: occupancy query failed (%d)\n", per_cu); (void)hipGetLastError(); per_cu = 1; }
        grid = cus * per_cu;
    }
    if (grid < 0) return;
    if (hipMemsetAsync(d_ws, 0, 131072, stream) != hipSuccess) { fprintf(stderr, "kernel_launch: memset of the barrier words failed\n"); return; }
    Params p{};
    for (int i = 0; i < 15; ++i) p.in[i] = (const float*)d_in[i];
    p.out = (float*)d_out; p.ws = (unsigned char*)d_ws;
    void* args[] = {&p};
    hipError_t e = hipLaunchCooperativeKernel((const void*)fwd_megakernel, dim3(grid), dim3(512), args, LDS_BYTES, stream);
    if (e != hipSuccess) fprintf(stderr, "kernel_launch: cooperative launch failed: %s (grid %d)\n", hipGetErrorString(e), grid);
}
```

```cpp
#include <hip/hip_runtime.h>
#include <hip/hip_cooperative_groups.h>
#include <cstdio>
#include <cstdint>
namespace cg = cooperative_groups;
namespace pg8 {
#define PG8_LAS __attribute__((address_space(3)))
typedef unsigned short bf16_t;
typedef short bf16x8 __attribute__((ext_vector_type(8)));
typedef float f32x4 __attribute__((ext_vector_type(4)));
typedef unsigned u32x4 __attribute__((ext_vector_type(4)));
constexpr int BM = 256, BK = 64, HALF = 128, HTB = HALF * BK * 2  , STAGE_BYTES = 8 * HTB, NXCD = 8, WGM = 8;

__host__ __device__ __forceinline__ int lds_byte(int r, int c) { const int st = (r >> 4) * 2 + (c >> 5), rr = r & 15, cc = c & 31, ob = rr * 64 + cc * 2; return st * 1024 + (ob ^ (((ob >> 9) & 1) << 5)); }
__host__ __device__ __forceinline__ void stage_rc(int b, int& R, int& C) { const int st = b / 1024, sb = b % 1024, swz = sb ^ (((sb >> 9) & 1) << 5); R = (st >> 1) * 16 + swz / 64; C = (st & 1) * 32 + (swz % 64) / 2; }
__host__ __device__ __forceinline__ int perm32(int rho) { const int n = rho >> 4, i = rho & 15; return 8 * (i >> 2) + 4 * n + (i & 3); }

struct Unit { int pm, pn; };
struct Gemm { const bf16_t* A; const bf16_t* Bt; int M, N, K; };

struct StaticOrder {
    int nM, nN, nwg, G, c;
    __host__ __device__ void init(int M, int N, int G_, int c_) { nM = M / BM; nN = N / BM; nwg = nM * nN; G = G_; c = c_; }
    __host__ __device__ bool next(int i, Unit& u) const {
        const long L = (long)i * G + c; if (L >= nwg) return false;
        int wgid = (int)L; { const int q = nwg / NXCD, r = nwg % NXCD, xcd = wgid % NXCD, off = wgid / NXCD; wgid = (xcd < r ? xcd * (q + 1) : r * (q + 1) + (xcd - r) * q) + off; }
        const int nig = WGM * nN, gid = wgid / nig, fm = gid * WGM, gsz = (nM - fm) < WGM ? (nM - fm) : WGM;
        u.pm = fm + ((wgid % nig) % gsz); u.pn = (wgid % nig) / gsz; return true;
    }
    __device__ __forceinline__ void a_ready(const Unit&) const {}
    __device__ __forceinline__ void done(const Unit&) const {}
};

typedef float f32x2 __attribute__((ext_vector_type(2)));
typedef __bf16 bf2_t __attribute__((ext_vector_type(2)));
__device__ __forceinline__ unsigned pk(float lo, float hi) { f32x2 v = {lo, hi}; bf2_t b = __builtin_convertvector(v, bf2_t); return __builtin_bit_cast(unsigned, b); }
__device__ __forceinline__ float sigm(float x) { return __builtin_amdgcn_rcpf(1.0f + __expf(-x)); }

template <int ACT  > struct EpiBf {
    static constexpr bool PERM = true, AFTER_DRAIN = false;
    bf16_t* O; size_t ldc;
    __device__ __forceinline__ void operator()(const f32x4 (&acc)[2][2][4][2], const Unit& u, int wr, int wc, int fr, int fq) const {
        const int row0 = u.pm * BM + wr * 64 + fr; const int col0 = u.pn * BM + wc * 32 + 8 * fq;
#pragma unroll
        for (int ai = 0; ai < 2; ++ai)
#pragma unroll
            for (int m = 0; m < 4; ++m) { bf16_t* rowp = O + (size_t)(row0 + ai * HALF + m * 16) * ldc + col0;
#pragma unroll
                for (int bj = 0; bj < 2; ++bj) { f32x4 v0 = acc[ai][bj][m][0], v1 = acc[ai][bj][m][1];
                    if (ACT == 1) {
#pragma unroll
                        for (int j = 0; j < 4; ++j) { const float a = fmaxf(v0[j], 0.f), b = fmaxf(v1[j], 0.f); v0[j] = a * a; v1[j] = b * b; } }
                    u32x4 w; w.x = pk(v0[0], v0[1]); w.y = pk(v0[2], v0[3]); w.z = pk(v1[0], v1[1]); w.w = pk(v1[2], v1[3]);
                    if (ACT == 1) __builtin_nontemporal_store(w, (u32x4*)(rowp + bj * HALF)); else *(u32x4*)(rowp + bj * HALF) = w; } }
    }
};

struct EpiWin {
    static constexpr bool PERM = true, AFTER_DRAIN = false;
    bf16_t *Q, *Kb, *G1, *U, *SGP; const float* rope;
    __device__ __forceinline__ void operator()(const f32x4 (&acc)[2][2][4][2], const Unit& u, int wr, int wc, int fr, int fq) const {
        const int pn = u.pn; const int row0 = u.pm * BM + wr * 64 + fr;
        if (pn < 4) {
            bf16_t* dst = pn < 2 ? Q : Kb; const int head = (pn & 1) * 4 + wc;
#pragma unroll
            for (int ai = 0; ai < 2; ++ai)
#pragma unroll
                for (int m = 0; m < 4; ++m) {
                    const int row = row0 + ai * HALF + m * 16; const int pos = row < 16384 ? row : ((row - 16384) & 4095);
                    const float* tp = rope + (size_t)pos * 64 + 8 * fq;
                    const f32x4 c0 = *(const f32x4*)(tp), c1 = *(const f32x4*)(tp + 4), s0 = *(const f32x4*)(tp + 32), s1 = *(const f32x4*)(tp + 36);
                    const f32x4 x1a = acc[ai][0][m][0], x1b = acc[ai][0][m][1], x2a = acc[ai][1][m][0], x2b = acc[ai][1][m][1];
                    const f32x4 o1a = x1a * c0 - x2a * s0, o1b = x1b * c1 - x2b * s1, o2a = x1a * s0 + x2a * c0, o2b = x1b * s1 + x2b * c1;
                    bf16_t* rp = dst + (size_t)row * 512 + head * 64 + 8 * fq;
                    u32x4 w1; w1.x = pk(o1a[0], o1a[1]); w1.y = pk(o1a[2], o1a[3]); w1.z = pk(o1b[0], o1b[1]); w1.w = pk(o1b[2], o1b[3]);
                    u32x4 w2; w2.x = pk(o2a[0], o2a[1]); w2.y = pk(o2a[2], o2a[3]); w2.z = pk(o2b[0], o2b[1]); w2.w = pk(o2b[2], o2b[3]);
                    *(u32x4*)rp = w1; *(u32x4*)(rp + 32) = w2; }
        } else if (pn < 12) {
            const int colb = (pn - 4) * 128 + wc * 32 + 8 * fq;
#pragma unroll
            for (int ai = 0; ai < 2; ++ai)
#pragma unroll
                for (int m = 0; m < 4; ++m) {
                    const int row = row0 + ai * HALF + m * 16; float o[8];
#pragma unroll
                    for (int n = 0; n < 2; ++n)
#pragma unroll
                        for (int j = 0; j < 4; ++j) { const float g = acc[ai][0][m][n][j], gr = acc[ai][1][m][n][j]; o[4 * n + j] = g * __builtin_amdgcn_rcpf((1.0f + __expf(-g)) * (1.0f + __expf(-gr))); }
                    u32x4 w; w.x = pk(o[0], o[1]); w.y = pk(o[2], o[3]); w.z = pk(o[4], o[5]); w.w = pk(o[6], o[7]);
                    __builtin_nontemporal_store(w, (u32x4*)(G1 + (size_t)row * 1024 + colb)); }
        } else {
            const bool sg = pn >= 16; bf16_t* dst = sg ? SGP : U; const int col0 = ((pn - 12) & 3) * BM + wc * 32 + 8 * fq;
#pragma unroll
            for (int ai = 0; ai < 2; ++ai)
#pragma unroll
                for (int m = 0; m < 4; ++m) { bf16_t* rowp = dst + (size_t)(row0 + ai * HALF + m * 16) * 1024 + col0;
#pragma unroll
                    for (int bj = 0; bj < 2; ++bj) { f32x4 v0 = acc[ai][bj][m][0], v1 = acc[ai][bj][m][1];
                        if (sg) {
#pragma unroll
                            for (int j = 0; j < 4; ++j) { v0[j] = sigm(v0[j]); v1[j] = sigm(v1[j]); } }
                        u32x4 w; w.x = pk(v0[0], v0[1]); w.y = pk(v0[2], v0[3]); w.z = pk(v1[0], v1[1]); w.w = pk(v1[2], v1[3]);
                        __builtin_nontemporal_store(w, (u32x4*)(rowp + bj * HALF)); } }
        }
    }
};

template <class Epi, class Sched, bool ALIGN_EPI = false, bool SP2 = false>
__device__ __forceinline__ void gemm_phase(PG8_LAS unsigned char* lds, const Gemm g, const Sched& S, const Epi& E) {
    int tid_l = threadIdx.x; asm volatile("" : "+v"(tid_l)); const int tid = tid_l, wid = __builtin_amdgcn_readfirstlane(tid >> 6), lane = tid & 63, wr = wid >> 2, wc = wid & 3, fr = lane & 15, fq = lane >> 4;
    const int K = g.K, nt = K / BK;
    unsigned voffA[2], voffB[2];
#pragma unroll
    for (int i = 0; i < 2; ++i) { int R, C; stage_rc(tid * 16 + i * 8192, R, C); const int Rb = Epi::PERM ? ((R & ~31) + perm32(R & 31)) : R;
        voffA[i] = (unsigned)(R * K + C) * 2u; voffB[i] = (unsigned)(Rb * K + C) * 2u; }
    const size_t kstep = (size_t)(BK * 2);
    const size_t hstep = (size_t)HALF * K * 2;
    const size_t tstep = 2 * hstep;
    const unsigned ldsw = (unsigned)wid * 1024u;
    const int aoff = lds_byte(wr * 64 + fr, fq * 8), boff = lds_byte(wc * 32 + fr, fq * 8);
#define PG8_SA(b, h) (((b) * 2 + (h)) * HTB)
#define PG8_SB(b, h) ((4 + (b) * 2 + (h)) * HTB)
#define PG8_STAGE(bufoff, gbase, voff) do { _Pragma("unroll") for (int _i = 0; _i < 2; ++_i) \
        __builtin_amdgcn_global_load_lds((const unsigned*)((const char*)(gbase) + (voff)[_i]), (PG8_LAS unsigned*)(lds + (bufoff) + ldsw + _i * 8192), 16, 0, 0); } while (0)
#define PG8_LDA(dst, b, h) do { _Pragma("unroll") for (int m = 0; m < 4; ++m) _Pragma("unroll") for (int k = 0; k < 2; ++k) dst[m][k] = *(const PG8_LAS bf16x8*)(lds + PG8_SA(b, h) + aoff + m * 2048 + k * 1024); } while (0)
#define PG8_LDB(dst, b, h) do { _Pragma("unroll") for (int n = 0; n < 2; ++n) _Pragma("unroll") for (int k = 0; k < 2; ++k) dst[n][k] = *(const PG8_LAS bf16x8*)(lds + PG8_SB(b, h) + boff + n * 2048 + k * 1024); } while (0)
#define PG8_MMA(ai, bj, At, Bt) do { __builtin_amdgcn_s_setprio(1); _Pragma("unroll") for (int m = 0; m < 4; ++m) _Pragma("unroll") for (int n = 0; n < 2; ++n) _Pragma("unroll") for (int k = 0; k < 2; ++k) \
        acc[ai][bj][m][n] = __builtin_amdgcn_mfma_f32_16x16x32_bf16(Bt[n][k], At[m][k], acc[ai][bj][m][n], 0, 0, 0); __builtin_amdgcn_s_setprio(0); } while (0)
#define PG8_WAIT_V(n) asm volatile("s_waitcnt vmcnt(" #n ")" ::: "memory")
#define PG8_WAIT_L(n) asm volatile("s_waitcnt lgkmcnt(" #n ")" ::: "memory")
#define PG8_BAR __builtin_amdgcn_s_barrier()
#define PG8_SCHED __builtin_amdgcn_sched_barrier(0)
    Unit cur, nxt; int ui = 0;
    if (!S.next(0, cur)) return;
    f32x4 acc[2][2][4][2];
#pragma unroll
    for (int a = 0; a < 2; ++a)
#pragma unroll
        for (int b = 0; b < 2; ++b)
#pragma unroll
            for (int m = 0; m < 4; ++m)
#pragma unroll
                for (int n = 0; n < 2; ++n) acc[a][b][m][n] = (f32x4){0.f, 0.f, 0.f, 0.f};
    bf16x8 At[4][2], B0[2][2], B1[2][2];
    const char* cA = (const char*)g.A + (size_t)cur.pm * tstep; const char* cB = (const char*)g.Bt + (size_t)cur.pn * tstep;
    S.a_ready(cur);
    if constexpr (SP2) {
        PG8_STAGE(PG8_SB(0, 0), cB, voffB); PG8_STAGE(PG8_SB(0, 1), cB + hstep, voffB); PG8_STAGE(PG8_SA(0, 0), cA, voffA); PG8_STAGE(PG8_SA(0, 1), cA + hstep, voffA);
        if (wr == 1) PG8_BAR;
        PG8_WAIT_V(2); PG8_BAR;
        PG8_STAGE(PG8_SB(1, 0), cB + kstep, voffB); PG8_STAGE(PG8_SA(1, 0), cA + kstep, voffA); PG8_STAGE(PG8_SB(1, 1), cB + hstep + kstep, voffB);
        PG8_WAIT_V(6); PG8_BAR;
    } else {
        PG8_STAGE(PG8_SB(0, 0), cB, voffB); PG8_STAGE(PG8_SA(0, 0), cA, voffA); PG8_STAGE(PG8_SB(0, 1), cB + hstep, voffB); PG8_STAGE(PG8_SA(0, 1), cA + hstep, voffA);
        if (wr == 1) PG8_BAR;
        PG8_WAIT_V(4); PG8_BAR;
        PG8_STAGE(PG8_SB(1, 0), cB + kstep, voffB); PG8_STAGE(PG8_SA(1, 0), cA + kstep, voffA); PG8_STAGE(PG8_SB(1, 1), cB + hstep + kstep, voffB);
        PG8_WAIT_V(6); PG8_BAR;
    }
    for (;;) {
        const bool has_next = S.next(ui + 1, nxt);
        const char* nA = has_next ? (const char*)g.A + (size_t)nxt.pm * tstep : cA; const char* nB = has_next ? (const char*)g.Bt + (size_t)nxt.pn * tstep : cB;
        for (int t = 0; t < nt; t += 2) {
            const bool last = (t == nt - 2);
            const char* a1 = cA + (size_t)(t + 1) * kstep;
            const char* a2 = last ? nA : cA + (size_t)(t + 2) * kstep; const char* b2 = last ? nB : cB + (size_t)(t + 2) * kstep;
            const char* a3 = a2 + kstep; const char* b3 = b2 + kstep;
            if (last && has_next) S.a_ready(nxt);
            if constexpr (SP2) {
            PG8_LDB(B0, 0, 0); PG8_LDB(B1, 0, 1); PG8_SCHED; PG8_LDA(At, 0, 0); PG8_STAGE(PG8_SA(1, 1), a1 + hstep, voffA);
            PG8_WAIT_V(8); PG8_WAIT_L(0); PG8_BAR; PG8_MMA(0, 0, At, B0); PG8_MMA(0, 1, At, B1); PG8_BAR; PG8_SCHED;
            PG8_LDA(At, 0, 1); PG8_STAGE(PG8_SB(0, 0), b2, voffB); PG8_STAGE(PG8_SB(0, 1), b2 + hstep, voffB); PG8_STAGE(PG8_SA(0, 0), a2, voffA);
            PG8_WAIT_V(8); PG8_WAIT_L(0); PG8_BAR; PG8_MMA(1, 0, At, B0); PG8_MMA(1, 1, At, B1); PG8_BAR; PG8_SCHED;
            PG8_LDB(B0, 1, 0); PG8_LDB(B1, 1, 1); PG8_SCHED; PG8_LDA(At, 1, 0); PG8_STAGE(PG8_SA(0, 1), a2 + hstep, voffA);
            PG8_WAIT_V(8); PG8_WAIT_L(0); PG8_BAR; PG8_MMA(0, 0, At, B0); PG8_MMA(0, 1, At, B1); PG8_BAR; PG8_SCHED;
            PG8_LDA(At, 1, 1); PG8_STAGE(PG8_SB(1, 0), b3, voffB); PG8_STAGE(PG8_SB(1, 1), b3 + hstep, voffB); PG8_STAGE(PG8_SA(1, 0), a3, voffA);
            PG8_WAIT_V(8); PG8_WAIT_L(0); PG8_BAR; PG8_MMA(1, 0, At, B0); PG8_MMA(1, 1, At, B1); PG8_BAR; PG8_SCHED;
            } else {
            PG8_LDB(B0, 0, 0); PG8_SCHED; PG8_LDA(At, 0, 0); PG8_STAGE(PG8_SA(1, 1), a1 + hstep, voffA);
            PG8_WAIT_L(8); PG8_BAR; PG8_WAIT_L(0); PG8_MMA(0, 0, At, B0); PG8_BAR; PG8_SCHED;
            PG8_LDB(B1, 0, 1); PG8_STAGE(PG8_SB(0, 0), b2, voffB);
            PG8_BAR; PG8_WAIT_L(0); PG8_MMA(0, 1, At, B1); PG8_BAR;
            PG8_LDA(At, 0, 1); PG8_STAGE(PG8_SA(0, 0), a2, voffA);
            PG8_BAR; PG8_WAIT_L(0); PG8_MMA(1, 0, At, B0); PG8_BAR; PG8_SCHED;
            PG8_STAGE(PG8_SB(0, 1), b2 + hstep, voffB);
            PG8_WAIT_V(6); PG8_BAR; PG8_MMA(1, 1, At, B1); PG8_BAR;
            PG8_LDB(B0, 1, 0); PG8_SCHED; PG8_LDA(At, 1, 0); PG8_STAGE(PG8_SA(0, 1), a2 + hstep, voffA);
            PG8_WAIT_L(8); PG8_BAR; PG8_WAIT_L(0); PG8_MMA(0, 0, At, B0); PG8_BAR; PG8_SCHED;
            PG8_LDB(B1, 1, 1); PG8_STAGE(PG8_SB(1, 0), b3, voffB);
            PG8_BAR; PG8_WAIT_L(0); PG8_MMA(0, 1, At, B1); PG8_BAR;
            PG8_LDA(At, 1, 1); PG8_STAGE(PG8_SA(1, 0), a3, voffA);
            PG8_BAR; PG8_WAIT_L(0); PG8_MMA(1, 0, At, B0); PG8_BAR; PG8_SCHED;
            PG8_STAGE(PG8_SB(1, 1), b3 + hstep, voffB);
            PG8_WAIT_V(6); PG8_BAR; PG8_MMA(1, 1, At, B1); PG8_BAR;
            }
        }
        if constexpr (ALIGN_EPI) { if (wr == 0) PG8_BAR; }
        if constexpr (!Epi::AFTER_DRAIN) { E(acc, cur, wr, wc, fr, fq); S.done(cur); }
        if (!has_next) break;
#pragma unroll
        for (int a = 0; a < 2; ++a)
#pragma unroll
            for (int b = 0; b < 2; ++b)
#pragma unroll
                for (int m = 0; m < 4; ++m)
#pragma unroll
                    for (int n = 0; n < 2; ++n) acc[a][b][m][n] = (f32x4){0.f, 0.f, 0.f, 0.f};
        cur = nxt; cA = nA; cB = nB; ++ui;
        if constexpr (ALIGN_EPI) { if (wr == 1) PG8_BAR; }
    }
    PG8_WAIT_V(0);
    if constexpr (!ALIGN_EPI) { if (wr == 0) PG8_BAR; }
    PG8_BAR;
    if constexpr (Epi::AFTER_DRAIN) { E.fused(acc, cur, wr, wc, fr, fq, lds, wid, lane); S.done(cur); }
#undef PG8_SA
#undef PG8_SB
#undef PG8_STAGE
#undef PG8_LDA
#undef PG8_LDB
#undef PG8_MMA
#undef PG8_WAIT_V
#undef PG8_WAIT_L
#undef PG8_BAR
#undef PG8_SCHED
}
}

#define DI __device__ __forceinline__
#define LAS __attribute__((address_space(3)))
typedef unsigned short bf16_t;
typedef short bf16x8 __attribute__((ext_vector_type(8)));
typedef float f32x4 __attribute__((ext_vector_type(4)));
typedef unsigned u32x4 __attribute__((ext_vector_type(4)));
typedef unsigned u32x2 __attribute__((ext_vector_type(2)));
using pg8::pk;
using pg8::sigm;

constexpr int DM = 1024, DEPTH = 4, SEQ_P = 16384, SEQ_S = 4096;
constexpr int MTOK = 81920, DIN = 6144, DFF = 4096, NWIN = 5120;
constexpr int NUNIT_R = 1280;
constexpr size_t MiB = 1u << 20;
constexpr size_t WS_BAR = 65536, WS_ROPE = 1 * MiB, WS_BTIN = 6 * MiB, WS_WVT = 16 * MiB, WS_BTO = 18 * MiB, WS_BT1 = 20 * MiB, WS_BT2 = 28 * MiB;
constexpr size_t WS_HM = 40 * MiB, WS_Q = 200 * MiB, WS_K = 280 * MiB, WS_VT = 360 * MiB, WS_G1 = 520 * MiB, WS_U = 680 * MiB, WS_SGP = 840 * MiB, WS_RS = 1000 * MiB, WS_END = 1001 * MiB;
constexpr size_t WS_Y = WS_Q, WS_F = WS_VT, WS_ST = WS_HM;
constexpr int LDS_BYTES = 147456;
#ifndef PH
#define PH 255
#endif
#ifndef GEMM_REP
#define GEMM_REP 1
#endif
#ifndef R3_REP
#define R3_REP 1
#endif
#ifndef E_REP
#define E_REP 1
#endif
#ifndef R1_REP
#define R1_REP 1
#endif
#ifndef CV_REP
#define CV_REP 1
#endif
#ifndef GA_REP
#define GA_REP 1
#endif
#ifndef GD_REP
#define GD_REP 1
#endif
#ifndef GF_REP
#define GF_REP 1
#endif
#ifndef GG_REP
#define GG_REP 1
#endif
#ifndef SKEW_A
#define SKEW_A 2600u
#endif
#ifndef SKEW_F
#define SKEW_F 2600u
#endif
#ifndef SYNC_REP
#define SYNC_REP 1
#endif
constexpr int L_QS = 0, L_KS = 18432, L_VT = 36864, L_KT = 71680, L_FF = 89088, L_FB = 107520, L_OS = 0, L_US = 36864, L_KT2 = 89088;

__device__ const double ROPE_INV[32] = {1.0, 0.7498942093324559, 0.5623413251903491, 0.4216965034285822, 0.31622776601683794, 0.23713737056616552, 0.1778279410038923, 0.1333521432163324, 0.1, 0.07498942093324558, 0.05623413251903491, 0.042169650342858224, 0.03162277660168379, 0.023713737056616554, 0.01778279410038923, 0.01333521432163324, 0.01, 0.007498942093324558, 0.005623413251903491, 0.004216965034285823, 0.0031622776601683794, 0.0023713737056616554, 0.0017782794100389228, 0.001333521432163324, 0.001, 0.0007498942093324559, 0.0005623413251903491, 0.00042169650342858224, 0.00031622776601683794, 0.00023713737056616554, 0.00017782794100389227, 0.0001333521432163324};

struct Params { const float* in[15]; float* out; unsigned char* ws; };


typedef const __attribute__((address_space(4))) unsigned char* kargp_t;
DI kargp_t kargs() { kargp_t k = (kargp_t)__builtin_amdgcn_kernarg_segment_ptr(); asm volatile("" : "+s"(k)); return k; }
DI const float* arg_in(int i) { return *(const float* const __attribute__((address_space(4)))*)(kargs() + 8 * i); }
DI float* arg_out() { return *(float* const __attribute__((address_space(4)))*)(kargs() + 120); }
DI unsigned char* arg_ws() { return *(unsigned char* const __attribute__((address_space(4)))*)(kargs() + 128); }

DI float bflo(unsigned w) { return __uint_as_float(w << 16); }
DI float bfhi(unsigned w) { return __uint_as_float(w & 0xffff0000u); }
DI float ex2(float x) { return __builtin_amdgcn_exp2f(x); }
DI float wave_sum(float v) {
#pragma unroll
    for (int o = 1; o < 64; o <<= 1) v += __shfl_xor(v, o);
    return v;
}
DI f32x4 mfma16(bf16x8 x, bf16x8 y, f32x4 c) { return __builtin_amdgcn_mfma_f32_16x16x32_bf16(x, y, c, 0, 0, 0); }
DI bf16x8 as_bf(u32x4 v) { return __builtin_bit_cast(bf16x8, v); }
DI float log2_gamma(float x) { return -log1pf(__expf(-x)) * 1.4426950408889634f; }

DI void tr_item(const float* Wsrc, int ldw, int k0, bf16_t* dst, int Kd, const float* gain, float scale, LAS float* scr, int lane) {
    float v[32];
    const float* src = Wsrc + (size_t)(k0 + (lane >> 5)) * ldw + (lane & 31);
#pragma unroll
    for (int i = 0; i < 32; ++i) v[i] = __builtin_nontemporal_load(src + (size_t)(2 * i) * ldw);
#pragma unroll
    for (int i = 0; i < 32; ++i) scr[(2 * i + (lane >> 5)) * 33 + (lane & 31)] = v[i];
    asm volatile("s_waitcnt lgkmcnt(0)" ::: "memory");
    const int c = lane & 7;
    f32x4 ga = {scale, scale, scale, scale}, gb = ga;
    if (gain) { ga = ga * *(const f32x4*)(gain + k0 + 8 * c); gb = gb * *(const f32x4*)(gain + k0 + 8 * c + 4); }
#pragma unroll
    for (int j = 0; j < 4; ++j) { const int n = (lane >> 3) + 8 * j; const LAS float* s = scr + (8 * c) * 33 + n;
        u32x4 o; o.x = pk(s[0 * 33] * ga[0], s[1 * 33] * ga[1]); o.y = pk(s[2 * 33] * ga[2], s[3 * 33] * ga[3]); o.z = pk(s[4 * 33] * gb[0], s[5 * 33] * gb[1]); o.w = pk(s[6 * 33] * gb[2], s[7 * 33] * gb[3]);
        *(u32x4*)(dst + (size_t)n * Kd + k0 + 8 * c) = o; }
    asm volatile("s_waitcnt lgkmcnt(0)" ::: "memory");
}

DI void convert_layer(int l, LAS unsigned char* lds, int gw, int NGW, int wave, int lane) {
    unsigned char* ws = arg_ws();
    LAS float* scr = (LAS float*)(lds + wave * 16384);
    const float* win = arg_in(4) + (size_t)l * DM * DIN; const float* gpre = arg_in(2) + l * DM;
    const float* wout = arg_in(10) + (size_t)l * DM * DM; const float* gmlp = arg_in(11) + l * DM;
    const float* w1 = arg_in(13) + (size_t)l * DM * DFF; const float* w2 = arg_in(14) + (size_t)l * DFF * DM;
    const float* pw = arg_in(8) + (size_t)l * 4 * 256 * 256; const float* psc = arg_in(9) + l * DM;
    bf16_t* BTin = (bf16_t*)(ws + WS_BTIN); bf16_t* WvT = (bf16_t*)(ws + WS_WVT); bf16_t* BTo = (bf16_t*)(ws + WS_BTO);
    bf16_t* BT1 = (bf16_t*)(ws + WS_BT1); bf16_t* BT2 = (bf16_t*)(ws + WS_BT2);
    for (int it = gw; it < 9216; it += NGW) {
        if (it < 2048) {
            const int sg = it >> 4, kb = it & 15; const int slot0 = sg < 96 ? sg * 32 : 4096 + (sg - 96) * 32;
            const int pn = slot0 >> 8, t = slot0 & 255, bj = t >> 7, wcid = (t >> 5) & 3; int src; float sc = 1.f;
            if (pn < 2) src = ((pn & 1) * 4 + wcid) * 64 + 32 * bj;
            else if (pn < 4) { src = 512 + ((pn & 1) * 4 + wcid) * 64 + 32 * bj; sc = 0.125f; }
            else if (pn < 12) src = (bj ? 4096 : 2048) + 128 * (pn - 4) + 32 * wcid;
            else src = 5120 + (slot0 - 4096);
            tr_item(win + src, DIN, 64 * kb, BTin + (size_t)slot0 * DM, DM, gpre, sc, scr, lane);
        } else if (it < 2560) { const int r = it - 2048, nb = r >> 4, kb = r & 15; tr_item(win + 1024 + 32 * nb, DIN, 64 * kb, WvT + (size_t)(32 * nb) * DM, DM, gpre, 1.f, scr, lane);
        } else if (it < 3072) { const int r = it - 2560, nb = r >> 4, kb = r & 15; tr_item(wout + 32 * nb, DM, 64 * kb, BTo + (size_t)(32 * nb) * DM, DM, nullptr, 1.f, scr, lane);
        } else if (it < 5120) { const int r = it - 3072, nb = r >> 4, kb = r & 15; tr_item(w1 + 32 * nb, DFF, 64 * kb, BT1 + (size_t)(32 * nb) * DM, DM, gmlp, 1.f, scr, lane);
        } else if (it < 7168) { const int r = it - 5120, nb = r >> 6, kb = r & 63; tr_item(w2 + 32 * nb, DM, 64 * kb, BT2 + (size_t)(32 * nb) * DFF, DFF, nullptr, 1.f, scr, lane);
        } else {
            const int fi = it - 7168, ng = fi & 15, kg = fi >> 4; const int g = ng >> 2, d = (ng & 3) * 64 + lane, n = 256 * g + d, k0 = 8 * kg;
            const float* pwp = pw + (size_t)g * 65536 + d;
            typedef const __attribute__((address_space(4))) float* cfp_t;
            cfp_t wp = (cfp_t)(win + (size_t)k0 * DIN + 3072 + g * 256);
            float a[8];
#pragma unroll
            for (int kk = 0; kk < 8; ++kk) a[kk] = 0.f;
#pragma unroll 1
            for (int c = 0; c < 256; c += 8) {
                float pv[8];
#pragma unroll
                for (int j = 0; j < 8; ++j) pv[j] = pwp[(c + j) * 256];
#pragma unroll
                for (int kk = 0; kk < 8; ++kk) {
#pragma unroll
                    for (int j = 0; j < 8; ++j) a[kk] += wp[(size_t)kk * DIN + c + j] * pv[j]; }
            }
            const float sn = psc[n];
#pragma unroll
            for (int kk = 0; kk < 8; ++kk) a[kk] *= sn * gpre[k0 + kk];
            u32x4 o; o.x = pk(a[0], a[1]); o.y = pk(a[2], a[3]); o.z = pk(a[4], a[5]); o.w = pk(a[6], a[7]);
            *(u32x4*)(BTin + (size_t)(3072 + n) * DM + k0) = o;
        }
    }
}

DI void e0_phase(const float* xa, const float* xb, bf16_t* XB, float* IS, int gw, int NGW, int lane) {
    for (int m = gw; m < MTOK; m += NGW) {
        const float* xr = m < SEQ_P ? xa + (size_t)m * DM : xb + (size_t)(m - SEQ_P) * DM;
        f32x4 xv[4]; float ss = 0.f;
#pragma unroll
        for (int j = 0; j < 4; ++j) { xv[j] = __builtin_nontemporal_load((const f32x4*)(xr + 4 * lane + 256 * j)); ss += xv[j][0] * xv[j][0] + xv[j][1] * xv[j][1] + xv[j][2] * xv[j][2] + xv[j][3] * xv[j][3]; }
        const float ms = wave_sum(ss) * (1.f / DM) + 1e-6f, r = rsqrtf(ms);
        if (lane == 0) IS[m] = sqrtf(ms);
#pragma unroll
        for (int j = 0; j < 4; ++j) { u32x2 o; o.x = pk(xv[j][0] * r, xv[j][1] * r); o.y = pk(xv[j][2] * r, xv[j][3] * r); *(u32x2*)(XB + (size_t)m * DM + 4 * lane + 256 * j) = o; }
    }
}
DI void e_phase(const bf16_t* Y, bf16_t* XB, float* IS, const float* gpost, float* out, int gw, int NGW, int lane, int do_store) {
    f32x4 g[4];
#pragma unroll
    for (int j = 0; j < 4; ++j) g[j] = *(const f32x4*)(gpost + 4 * lane + 256 * j);
#pragma unroll 1
    for (int m0 = gw; m0 < MTOK; m0 += 2 * NGW) {
        u32x2 xb2[2][4], yb[2][4]; float isv[2]; const int nr = (m0 + NGW < MTOK) ? 2 : 1;
#pragma unroll
        for (int rr = 0; rr < 2; ++rr) { const int m = rr < nr ? m0 + rr * NGW : m0; isv[rr] = IS[m];
#pragma unroll
            for (int j = 0; j < 4; ++j) { yb[rr][j] = __builtin_nontemporal_load((const u32x2*)(Y + (size_t)m * DM + 4 * lane + 256 * j)); xb2[rr][j] = *(const u32x2*)(XB + (size_t)m * DM + 4 * lane + 256 * j); } }
#pragma unroll
        for (int rr = 0; rr < 2; ++rr) { const int m = m0 + rr * NGW;
            f32x4 yv[4], xv[4]; float ss = 0.f;
#pragma unroll
            for (int j = 0; j < 4; ++j) { yv[j] = (f32x4){bflo(yb[rr][j].x), bfhi(yb[rr][j].x), bflo(yb[rr][j].y), bfhi(yb[rr][j].y)}; xv[j] = (f32x4){bflo(xb2[rr][j].x), bfhi(xb2[rr][j].x), bflo(xb2[rr][j].y), bfhi(xb2[rr][j].y)} * isv[rr];
                ss += yv[j][0] * yv[j][0] + yv[j][1] * yv[j][1] + yv[j][2] * yv[j][2] + yv[j][3] * yv[j][3]; }
            const float ry = rsqrtf(wave_sum(ss) * (1.f / DM) + 1e-6f); float s1 = 0.f;
#pragma unroll
            for (int j = 0; j < 4; ++j) { xv[j] = xv[j] + yv[j] * ry * g[j]; s1 += xv[j][0] * xv[j][0] + xv[j][1] * xv[j][1] + xv[j][2] * xv[j][2] + xv[j][3] * xv[j][3]; }
            if (rr < nr) {
                if (out) {
#pragma unroll
                    for (int j = 0; j < 4; ++j) if (do_store) __builtin_nontemporal_store(xv[j], (f32x4*)(out + (size_t)m * DM + 4 * lane + 256 * j));
                } else {
                    const float ms = wave_sum(s1) * (1.f / DM) + 1e-6f, r1 = rsqrtf(ms);
                    if (lane == 0 && do_store) IS[m] = sqrtf(ms);
#pragma unroll
                    for (int j = 0; j < 4; ++j) { u32x2 o; o.x = pk(xv[j][0] * r1, xv[j][1] * r1); o.y = pk(xv[j][2] * r1, xv[j][3] * r1); if (do_store) *(u32x2*)(XB + (size_t)m * DM + 4 * lane + 256 * j) = o; }
                }
            }
        }
    }
}

DI void state_mma(f32x4 (&acc)[4], LAS unsigned char* Kt, LAS unsigned char* Vt, int w, int r, int q) {
#pragma unroll
    for (int s4 = 0; s4 < 4; ++s4) {
        const bf16x8 vy = *(const LAS bf16x8*)(Vt + (16 * w + r) * 272 + (32 * s4 + 8 * q) * 2);
#pragma unroll
        for (int dt = 0; dt < 4; ++dt) { const bf16x8 kx = *(const LAS bf16x8*)(Kt + (16 * dt + r) * 272 + (32 * s4 + 8 * q) * 2); acc[dt] = mfma16(kx, vy, acc[dt]); }
    }
}
DI void write_kt(LAS unsigned char* Kt, const u32x4 ka, const u32x4 kb, float za, float zb, int w, int lane) {
#pragma unroll
    for (int e = 0; e < 8; ++e) { const unsigned wa = ka[e >> 1], wb = kb[e >> 1]; const float a = (e & 1) ? bfhi(wa) : bflo(wa), b = (e & 1) ? bfhi(wb) : bflo(wb);
        *(LAS unsigned*)(Kt + (8 * w + e) * 272 + lane * 4) = pk(a * za, b * zb); }
}
DI void load_k(const bf16_t* Kb, int row0, int h, int w, int lane, u32x4& ka, u32x4& kb) {
    const bf16_t* pk0 = Kb + (size_t)(row0 + 2 * lane) * 512 + h * 64 + 8 * w; ka = *(const u32x4*)pk0; kb = *(const u32x4*)(pk0 + 512);
}
DI void load_vt(const bf16_t* VT, int row0, int h, int tid, u32x4 (&vv)[4]) {
#pragma unroll
    for (int it = 0; it < 4; ++it) { const int item = tid + 512 * it, dv = item >> 4, tg = item & 15; vv[it] = *(const u32x4*)(VT + (size_t)(h * 128 + dv) * MTOK + row0 + 8 * tg); }
}
DI void write_vt(LAS unsigned char* Vt, int tid, const u32x4 (&vv)[4]) {
#pragma unroll
    for (int it = 0; it < 4; ++it) { const int item = tid + 512 * it, dv = item >> 4, tg = item & 15; *(LAS u32x4*)(Vt + dv * 272 + tg * 16) = vv[it]; }
}

DI void r1_phase(LAS unsigned char* lds, const bf16_t* Kb, const bf16_t* VT, f32x4* ST, const float* decf, const float* decb, int G, int bid, int tid) {
    const int lane = tid & 63, w = __builtin_amdgcn_readfirstlane(tid >> 6), r = lane & 15, q = lane >> 4;
    LAS unsigned char* Vt = lds + L_VT; LAS unsigned char* Ktf = lds + L_KT; LAS unsigned char* Ktb = lds + L_KT2;
#pragma unroll 1
    for (int u = bid; u < NUNIT_R; u += G) {
        const int seg = u >> 3, h = u & 7;
        const float lf2 = log2_gamma(decf[h]), lb2 = log2_gamma(decb[h]);
        f32x4 accF[4], accB[4];
#pragma unroll
        for (int dt = 0; dt < 4; ++dt) { accF[dt] = (f32x4){0.f, 0.f, 0.f, 0.f}; accB[dt] = (f32x4){0.f, 0.f, 0.f, 0.f}; }
        u32x4 ka, kb, vv[4];
        load_k(Kb, seg * 512, h, w, lane, ka, kb); load_vt(VT, seg * 512, h, tid, vv);
#pragma unroll 1
        for (int c = 0; c < 4; ++c) {
            const float tl = (float)(c * 128 + 2 * lane);
            const float zf0 = ex2((511.f - tl) * lf2), zf1 = ex2((510.f - tl) * lf2), zb0 = ex2(tl * lb2), zb1 = ex2((tl + 1.f) * lb2);
            __syncthreads();
            write_kt(Ktf, ka, kb, zf0, zf1, w, lane); write_kt(Ktb, ka, kb, zb0, zb1, w, lane); write_vt(Vt, tid, vv);
            __syncthreads();
            if (c < 3) { const int row1 = seg * 512 + (c + 1) * 128; load_k(Kb, row1, h, w, lane, ka, kb); load_vt(VT, row1, h, tid, vv); }
            state_mma(accF, Ktf, Vt, w, r, q); state_mma(accB, Ktb, Vt, w, r, q);
        }
#pragma unroll
        for (int dt = 0; dt < 4; ++dt) { ST[((size_t)u * 2 + 0) * 2048 + tid * 4 + dt] = accF[dt]; ST[((size_t)u * 2 + 1) * 2048 + tid * 4 + dt] = accB[dt]; }
    }
}

#define R3_IDS int tid = tid0; asm volatile("" : "+v"(tid)); const int lane = tid & 63, r = lane & 15, q = lane >> 4; (void)r; (void)q; (void)lane;
struct R3Stage { u32x4 ka, kb, vv[4], qv[2], bs0, bs1; };
DI void r3_preload(R3Stage& st, const bf16_t* Qb, const bf16_t* Kb, const bf16_t* VT, const u32x4* BSV, int row0, int c, int h, int w, int tid0) {
    R3_IDS
    load_k(Kb, row0, h, w, lane, st.ka, st.kb); load_vt(VT, row0, h, tid, st.vv);
#pragma unroll
    for (int it = 0; it < 2; ++it) { const int item = tid + 512 * it, tok = item >> 3, g8 = item & 7; st.qv[it] = *(const u32x4*)(Qb + (size_t)(row0 + tok) * 512 + h * 64 + 8 * g8); }
    st.bs0 = __builtin_nontemporal_load(BSV + (c * 512 + tid) * 2); st.bs1 = __builtin_nontemporal_load(BSV + (c * 512 + tid) * 2 + 1);
}
DI void r3_phase(LAS unsigned char* lds, const bf16_t* Qb, const bf16_t* Kb, const bf16_t* VT, bf16_t* G1, const bf16_t* U, const bf16_t* SGP, const f32x4* ST, u32x4* BSV,
                 const float* decf, const float* decb, const float* gn, int G, int bid, int tid0, int do_store) {
    const int w = __builtin_amdgcn_readfirstlane(tid0 >> 6);
    LAS unsigned char* Qs = lds + L_QS; LAS unsigned char* Ks = lds + L_KS; LAS unsigned char* Vt = lds + L_VT; LAS unsigned char* Kt = lds + L_KT;
    LAS unsigned char* Ff = lds + L_FF; LAS unsigned char* Fb = lds + L_FB; LAS unsigned char* Os = lds + L_OS; LAS unsigned char* Us = lds + L_US;
#pragma unroll 1
    for (int u = bid; u < NUNIT_R; u += G) {
        const int seg = u >> 3, h = u & 7;
        const int s_lo = seg < 32 ? 0 : 32 + ((seg - 32) & ~7), s_hi = seg < 32 ? 32 : s_lo + 8;
        const int seqlo = s_lo * 512, seqhi = s_hi * 512;
        const float lf2 = log2_gamma(decf[h]), lb2 = log2_gamma(decb[h]);
        const float cdf = ex2(128.f * lf2), cdb = ex2(128.f * lb2);
        f32x4 accF[4], accB[4];
#pragma unroll
        for (int dt = 0; dt < 4; ++dt) { accF[dt] = (f32x4){0.f, 0.f, 0.f, 0.f}; accB[dt] = (f32x4){0.f, 0.f, 0.f, 0.f}; }
        { R3_IDS
          const int nf = min(seg - s_lo, (int)fminf(83.f / fmaxf(-512.f * lf2, 1e-6f), 64.f) + 1), nb = min(s_hi - 1 - seg, (int)fminf(83.f / fmaxf(-512.f * lb2, 1e-6f), 64.f) + 1);
#pragma unroll 4
          for (int i = 0; i < nf; ++i) { const f32x4* sp = ST + ((size_t)((seg - 1 - i) * 8 + h) * 2 + 0) * 2048 + tid * 4; const float fac = ex2(512.f * lf2 * (float)i);
#pragma unroll
              for (int dt = 0; dt < 4; ++dt) accF[dt] += sp[dt] * fac; }
#pragma unroll 4
          for (int i = 0; i < nb; ++i) { const f32x4* sp = ST + ((size_t)((seg + 1 + i) * 8 + h) * 2 + 1) * 2048 + tid * 4; const float fac = ex2(512.f * lb2 * (float)i);
#pragma unroll
              for (int dt = 0; dt < 4; ++dt) accB[dt] += sp[dt] * fac; } }
        { u32x4 ka, kb, vv[4];
          { R3_IDS load_k(Kb, seg * 512 + 384, h, w, lane, ka, kb); load_vt(VT, seg * 512 + 384, h, tid, vv); }
#pragma unroll 1
          for (int c = 3; c >= 0; --c) {
            R3_IDS
            { u32x4 p0, p1; p0.x = pk(accB[0][0], accB[0][1]); p0.y = pk(accB[0][2], accB[0][3]); p0.z = pk(accB[1][0], accB[1][1]); p0.w = pk(accB[1][2], accB[1][3]);
              p1.x = pk(accB[2][0], accB[2][1]); p1.y = pk(accB[2][2], accB[2][3]); p1.z = pk(accB[3][0], accB[3][1]); p1.w = pk(accB[3][2], accB[3][3]);
              BSV[(c * 512 + tid) * 2] = p0; BSV[(c * 512 + tid) * 2 + 1] = p1; }
            if (c == 0) break;
            const float tj = (float)(2 * lane); const float zb0 = ex2(tj * lb2), zb1 = ex2((tj + 1.f) * lb2);
            __syncthreads();
            write_kt(Kt, ka, kb, zb0, zb1, w, lane); write_vt(Vt, tid, vv);
            __syncthreads();
            if (c > 1) { const int row1 = seg * 512 + (c - 1) * 128; load_k(Kb, row1, h, w, lane, ka, kb); load_vt(VT, row1, h, tid, vv); }
#pragma unroll
            for (int dt = 0; dt < 4; ++dt) accB[dt] *= cdb;
            state_mma(accB, Kt, Vt, w, r, q);
          } }
        const int half = 1 << (h >> 1);
        R3Stage st;
        r3_preload(st, Qb, Kb, VT, BSV, seg * 512, 0, h, w, tid0);
#pragma unroll 1
        for (int c = 0; c < 4; ++c) {
            const int row0 = seg * 512 + c * 128;
            { R3_IDS
              const float tj = (float)(2 * lane); const float zf0 = ex2((127.f - tj) * lf2), zf1 = ex2((126.f - tj) * lf2);
              __syncthreads();
              write_kt(Kt, st.ka, st.kb, zf0, zf1, w, lane); write_vt(Vt, tid, st.vv);
              *(LAS u32x4*)(Ks + (2 * lane) * 144 + 16 * w) = st.ka; *(LAS u32x4*)(Ks + (2 * lane + 1) * 144 + 16 * w) = st.kb;
#pragma unroll
              for (int it = 0; it < 2; ++it) { const int item = tid + 512 * it, tok = item >> 3, g8 = item & 7; *(LAS u32x4*)(Qs + tok * 144 + 16 * g8) = st.qv[it]; }
#pragma unroll
              for (int dt = 0; dt < 4; ++dt) {
                u32x2 ff; ff.x = pk(accF[dt][0], accF[dt][1]); ff.y = pk(accF[dt][2], accF[dt][3]);
                *(LAS u32x2*)(Ff + (16 * w + r) * 144 + (16 * dt + 4 * q) * 2) = ff;
                u32x2 fb; fb.x = dt < 2 ? st.bs0[2 * dt] : st.bs1[2 * dt - 4]; fb.y = dt < 2 ? st.bs0[2 * dt + 1] : st.bs1[2 * dt - 3];
                *(LAS u32x2*)(Fb + (16 * w + r) * 144 + (16 * dt + 4 * q) * 2) = fb; }
              __syncthreads(); }
            u32x4 uv[5], g1v[4], sgv[4];
            { R3_IDS
#pragma unroll
              for (int it = 0; it < 5; ++it) { const int item = tid + 512 * it, rr = item >> 4, cgp = item & 15, grow = row0 - 8 + rr; uv[it] = (u32x4){0u, 0u, 0u, 0u};
                if (item < 2304 && grow >= seqlo && grow < seqhi) uv[it] = __builtin_nontemporal_load((const u32x4*)(U + (size_t)grow * DM + h * 128 + 8 * cgp)); }
#pragma unroll
              for (int it = 0; it < 4; ++it) { const int tok = 4 * (tid >> 4) + it, cgp = tid & 15; const size_t goff = (size_t)(row0 + tok) * DM + h * 128 + 8 * cgp;
                g1v[it] = __builtin_nontemporal_load((const u32x4*)(G1 + goff)); sgv[it] = __builtin_nontemporal_load((const u32x4*)(SGP + goff)); } }
            f32x4 ao[8]; float rs;
            { R3_IDS
              u32x4 qf[2];
#pragma unroll
              for (int s = 0; s < 2; ++s) qf[s] = *(const LAS u32x4*)(Qs + (16 * w + r) * 144 + (32 * s + 8 * q) * 2);
              f32x4 as[8];
#pragma unroll
              for (int jt = 0; jt < 8; ++jt) { as[jt] = (f32x4){0.f, 0.f, 0.f, 0.f};
#pragma unroll
                for (int s = 0; s < 2; ++s) { const bf16x8 kx = *(const LAS bf16x8*)(Ks + (16 * jt + r) * 144 + (32 * s + 8 * q) * 2); as[jt] = mfma16(kx, as_bf(qf[s]), as[jt]); } }
              const int i = 16 * w + r;
              {
                const int base = i - 4 * q;
                float ef = ex2((float)base * lf2), eb = ex2(-(float)base * lb2);
                const float c16f = ex2(-16.f * lf2), c16b = ex2(16.f * lb2), c1f = ex2(-lf2), c1b = ex2(lb2);
                float tf[4], tb[4]; tf[0] = 1.f; tb[0] = 1.f;
#pragma unroll
                for (int jj = 1; jj < 4; ++jj) { tf[jj] = tf[jj - 1] * c1f; tb[jj] = tb[jj - 1] * c1b; }
#pragma unroll
                for (int jt = 0; jt < 8; ++jt) {
#pragma unroll
                    for (int jj = 0; jj < 4; ++jj) { const int d = base - 16 * jt - jj; as[jt][jj] *= (d >= 0) ? ef * tf[jj] : eb * tb[jj]; }
                    ef *= c16f; eb *= c16b; } }
              u32x4 pf[4];
#pragma unroll
              for (int s2 = 0; s2 < 4; ++s2) { pf[s2].x = pk(as[2 * s2][0], as[2 * s2][1]); pf[s2].y = pk(as[2 * s2][2], as[2 * s2][3]); pf[s2].z = pk(as[2 * s2 + 1][0], as[2 * s2 + 1][1]); pf[s2].w = pk(as[2 * s2 + 1][2], as[2 * s2 + 1][3]); }
              const float xf = ex2((float)(i + 1) * lf2), xb = ex2((float)(128 - i) * lb2);
              u32x4 qff[2], qbb[2];
#pragma unroll
              for (int s = 0; s < 2; ++s)
#pragma unroll
                for (int k = 0; k < 4; ++k) { const float lo = bflo(qf[s][k]), hi = bfhi(qf[s][k]); qff[s][k] = pk(lo * xf, hi * xf); qbb[s][k] = pk(lo * xb, hi * xb); }
              __builtin_amdgcn_sched_barrier(0);
#pragma unroll
              for (int t = 0; t < 8; ++t) { ao[t] = (f32x4){0.f, 0.f, 0.f, 0.f};
#pragma unroll
                for (int s2 = 0; s2 < 4; ++s2) { const u32x2 lo = *(const LAS u32x2*)(Vt + (16 * t + r) * 272 + (32 * s2 + 4 * q) * 2), hi = *(const LAS u32x2*)(Vt + (16 * t + r) * 272 + (32 * s2 + 16 + 4 * q) * 2);
                    const u32x4 vx = {lo.x, lo.y, hi.x, hi.y}; ao[t] = mfma16(as_bf(vx), as_bf(pf[s2]), ao[t]); }
#pragma unroll
                for (int s = 0; s < 2; ++s) { const bf16x8 fx = *(const LAS bf16x8*)(Ff + (16 * t + r) * 144 + (32 * s + 8 * q) * 2); ao[t] = mfma16(fx, as_bf(qff[s]), ao[t]);
                    const bf16x8 bx = *(const LAS bf16x8*)(Fb + (16 * t + r) * 144 + (32 * s + 8 * q) * 2); ao[t] = mfma16(bx, as_bf(qbb[s]), ao[t]); }
                if (t & 1) __builtin_amdgcn_sched_barrier(0); }
              if (c < 3) {
#pragma unroll
                for (int dt = 0; dt < 4; ++dt) accF[dt] *= cdf;
                state_mma(accF, Kt, Vt, w, r, q); }
              __builtin_amdgcn_sched_barrier(0);
              float s1 = 0.f;
#pragma unroll
              for (int t = 0; t < 8; ++t) s1 += (ao[t][0] + ao[t][1]) + (ao[t][2] + ao[t][3]);
              s1 += __shfl_xor(s1, 16); s1 += __shfl_xor(s1, 32);
              const float mu = s1 * (1.f / 128.f); float s2v = 0.f;
#pragma unroll
              for (int t = 0; t < 8; ++t) { ao[t] = ao[t] - mu; s2v += (ao[t][0] * ao[t][0] + ao[t][1] * ao[t][1]) + (ao[t][2] * ao[t][2] + ao[t][3] * ao[t][3]); }
              s2v += __shfl_xor(s2v, 16); s2v += __shfl_xor(s2v, 32);
              rs = rsqrtf(s2v * (1.f / 128.f) + 1e-6f); }
            if (c < 3) r3_preload(st, Qb, Kb, VT, BSV, row0 + 128, c + 1, h, w, tid0);
            __syncthreads();
            { R3_IDS
#pragma unroll
              for (int t = 0; t < 8; ++t) { u32x2 o; o.x = pk(ao[t][0] * rs, ao[t][1] * rs); o.y = pk(ao[t][2] * rs, ao[t][3] * rs); *(LAS u32x2*)(Os + (16 * w + r) * 272 + (16 * t + 4 * q) * 2) = o; }
#pragma unroll
              for (int it = 0; it < 5; ++it) { const int item = tid + 512 * it, rr = item >> 4, cgp = item & 15; if (item < 2304) *(LAS u32x4*)(Us + rr * 272 + cgp * 16) = uv[it]; }
              __syncthreads(); }
            { R3_IDS
              const int cgp = tid & 15, tok0 = 4 * (tid >> 4);
              const f32x4 ga = *(const f32x4*)(gn + h * 128 + 8 * cgp), gb = *(const f32x4*)(gn + h * 128 + 8 * cgp + 4);
              float a8[8];
#pragma unroll
              for (int k = 0; k < 8; ++k) a8[k] = 0.f;
              int lo_c = max(row0 + tok0 - half, seqlo), hi_c = lo_c;
#pragma unroll
              for (int it = 0; it < 4; ++it) {
                const int tok = tok0 + it, grow = row0 + tok;
                const size_t goff = (size_t)grow * DM + h * 128 + 8 * cgp;
                const u32x4 g1 = g1v[it], sg = sgv[it];
                const u32x4 on = *(const LAS u32x4*)(Os + tok * 272 + cgp * 16);
                const int lo = max(grow - half, seqlo), hi = min(grow + half, seqhi);
#pragma unroll 1
                for (; hi_c < hi; ++hi_c) { const u32x4 uw = *(const LAS u32x4*)(Us + (hi_c - row0 + 8) * 272 + cgp * 16);
#pragma unroll
                    for (int k = 0; k < 4; ++k) { a8[2 * k] += bflo(uw[k]); a8[2 * k + 1] += bfhi(uw[k]); } }
#pragma unroll 1
                for (; lo_c < lo; ++lo_c) { const u32x4 uw = *(const LAS u32x4*)(Us + (lo_c - row0 + 8) * 272 + cgp * 16);
#pragma unroll
                    for (int k = 0; k < 4; ++k) { a8[2 * k] -= bflo(uw[k]); a8[2 * k + 1] -= bfhi(uw[k]); } }
                const u32x4 own = *(const LAS u32x4*)(Us + (tok + 8) * 272 + cgp * 16);
                const float inv = 1.f / (float)(hi - lo);
                float mo[8];
#pragma unroll
                for (int k = 0; k < 4; ++k) {
                    const float gl = k < 2 ? ga[2 * k] : gb[2 * k - 4], gh = k < 2 ? ga[2 * k + 1] : gb[2 * k - 3];
                    mo[2 * k] = bflo(g1[k]) * bflo(on[k]) * gl + bflo(sg[k]) * (a8[2 * k] * inv - bflo(own[k]));
                    mo[2 * k + 1] = bfhi(g1[k]) * bfhi(on[k]) * gh + bfhi(sg[k]) * (a8[2 * k + 1] * inv - bfhi(own[k])); }
                u32x4 o; o.x = pk(mo[0], mo[1]); o.y = pk(mo[2], mo[3]); o.z = pk(mo[4], mo[5]); o.w = pk(mo[6], mo[7]);
                if (do_store) *(u32x4*)(G1 + goff) = o;
              } }
        }
    }
}


DI void phase_skew(int bid, unsigned span_ticks) {
    const unsigned d = (unsigned)((bid >> 3) & 31) * span_ticks / 32u;
    const unsigned long long t0 = __builtin_amdgcn_s_memrealtime();
    while ((unsigned)(__builtin_amdgcn_s_memrealtime() - t0) < d) __builtin_amdgcn_s_sleep(16);
}

#define XB_TMO      128
#define XB_XCNT(j)  (256  + 64 * (j))
#define XB_XSUB(j)  (1280 + 64 * (j))
#define XB_XGEN(j)  (2304 + 64 * (j))
#define XB_TOP      3328
#define XB_TOPGEN   3392
#define XCD_BAR_WORDS 3456
#define XB_SPIN_CAP (1u << 18)

__device__ __forceinline__ unsigned xb_ld(unsigned* p)              { return __hip_atomic_load(p, __ATOMIC_RELAXED, __HIP_MEMORY_SCOPE_AGENT); }
__device__ __forceinline__ unsigned xb_add(unsigned* p, unsigned v) { return __hip_atomic_fetch_add(p, v, __ATOMIC_RELAXED, __HIP_MEMORY_SCOPE_AGENT); }
__device__ __forceinline__ unsigned xb_xcc_id() { return (unsigned)__builtin_amdgcn_s_getreg((3 << 11) | 20) & 0xFu; }
#define XB_SPIN(cond, bar) do { unsigned _sp = 0; while (cond) { __builtin_amdgcn_s_sleep(1); \
    if ((++_sp & 255u) == 0u) { if (xb_ld(&(bar)[XB_TMO])) break; if (_sp > XB_SPIN_CAP) { atomicAdd(&(bar)[XB_TMO], 1u); break; } } } } while (0)

struct XcdBarrier {
    unsigned* bar; unsigned x;
    volatile LAS unsigned* st;
};

__device__ __forceinline__ XcdBarrier xcd_barrier_post(unsigned* bar, volatile LAS unsigned* st) {
    XcdBarrier b; b.bar = bar; b.x = xb_xcc_id(); b.st = st;
    if (threadIdx.x == 0) (void)xb_add(&bar[XB_XCNT(b.x)], 1u);
    return b;
}
__device__ __forceinline__ void xcd_barrier_complete(unsigned* bar, unsigned x, unsigned& nloc, unsigned& nx) {
    const unsigned G = gridDim.x * gridDim.y * gridDim.z;
    unsigned sum, cnt, mine, sp = 0u;
    for (;;) {
        sum = 0u; cnt = 0u; mine = 0u;
#pragma unroll
        for (unsigned j = 0; j < 16; ++j) { const unsigned c = xb_ld(&bar[XB_XCNT(j)]); sum += c; cnt += (c > 0u) ? 1u : 0u; mine = (j == x) ? c : mine; }
        if (sum == G) break;
        __builtin_amdgcn_s_sleep(1);
        if ((++sp & 255u) == 0u) { if (xb_ld(&bar[XB_TMO])) break; if (sp > XB_SPIN_CAP) { atomicAdd(&bar[XB_TMO], 1u); break; } }
    }
    nloc = mine > 0u ? mine : 1u; nx = cnt > 0u ? cnt : 1u;
}

__device__ __forceinline__ void xcd_barrier(const XcdBarrier& b) {
    asm volatile("s_waitcnt vmcnt(0)" ::: "memory");
    __syncthreads();
    if (threadIdx.x == 0) {
        unsigned* bar = b.bar;
        __builtin_amdgcn_s_waitcnt(0);
        unsigned nloc = b.st[0], nx = b.st[1];
        if (nloc == 0u) { xcd_barrier_complete(bar, b.x, nloc, nx); b.st[0] = nloc; b.st[1] = nx; }
        const unsigned old = xb_add(&bar[XB_XSUB(b.x)], 1u);
        const unsigned gen = old / nloc;
        if (old + 1u == (gen + 1u) * nloc) {
            __builtin_amdgcn_fence(__ATOMIC_RELEASE, "agent");
            asm volatile("s_waitcnt vmcnt(0)" ::: "memory");
            const unsigned og = xb_add(&bar[XB_TOP], 1u);
            const unsigned tg = og / nx;
            if (og + 1u == (tg + 1u) * nx) xb_add(&bar[XB_TOPGEN], 1u);
            else XB_SPIN(xb_ld(&bar[XB_TOPGEN]) == tg, bar);
            __builtin_amdgcn_fence(__ATOMIC_ACQUIRE, "agent");
            xb_add(&bar[XB_XGEN(b.x)], 1u);
            asm volatile("s_waitcnt vmcnt(0)" ::: "memory");
        } else {
            XB_SPIN(xb_ld(&bar[XB_XGEN(b.x)]) == gen, bar);
            __builtin_amdgcn_fence(__ATOMIC_ACQUIRE, "agent");
            asm volatile("s_waitcnt vmcnt(0)" ::: "memory");
        }
    }
    __syncthreads();
}

__global__ void __launch_bounds__(512, 2) fwd_megakernel(Params p) {
    extern __shared__ __attribute__((aligned(16))) unsigned char lds_raw[];
    LAS unsigned char* lds = (LAS unsigned char*)lds_raw;
    cg::grid_group grid = cg::this_grid();
    volatile LAS unsigned* bst = (volatile LAS unsigned*)(lds + 139264);
    if (threadIdx.x < 2) bst[threadIdx.x] = 0u;
    __syncthreads();
    (void)xcd_barrier_post((unsigned*)(arg_ws() + WS_BAR), bst);
#define GRID_BAR() do { XcdBarrier b_; b_.bar = (unsigned*)(arg_ws() + WS_BAR); b_.x = xb_xcc_id(); b_.st = bst; xcd_barrier(b_); } while (0)
#define FRESH_IDS int tid = threadIdx.x; asm volatile("" : "+v"(tid)); const int lane = tid & 63, wave = __builtin_amdgcn_readfirstlane(tid >> 6); const int G = gridDim.x, bid = blockIdx.x, gw = bid * 8 + wave, NGW = G * 8; (void)lane; (void)gw; (void)NGW;
#define WSB(T, off) ((T*)(arg_ws() + (off)))

    { FRESH_IDS float* rope = WSB(float, WS_ROPE);
      for (int e = bid * 512 + tid; e < SEQ_P * 32; e += G * 512) {
        const int pos = e >> 5, i = e & 31; double rev = (double)pos * ROPE_INV[i] * 0.15915494309189535; rev -= floor(rev); const float rf = (float)rev;
        rope[pos * 64 + i] = __builtin_amdgcn_cosf(rf); rope[pos * 64 + 32 + i] = __builtin_amdgcn_sinf(rf); } }
#if PH & 1
    { FRESH_IDS convert_layer(0, lds, gw, NGW, wave, lane); }
#endif
    { FRESH_IDS e0_phase(arg_in(0), arg_in(1), WSB(bf16_t, WS_HM), WSB(float, WS_RS), gw, NGW, lane); }
    grid.sync();

#pragma unroll 1
    for (int l = 0; l < DEPTH; ++l) {
#if PH & 2
        _Pragma("unroll 1") for (int rep = 0; rep < GA_REP; ++rep)
        { FRESH_IDS unsigned char* ws = arg_ws();
          pg8::Gemm g{(bf16_t*)(ws + WS_HM), (bf16_t*)(ws + WS_BTIN), MTOK, NWIN, DM}; pg8::StaticOrder S; S.init(MTOK, NWIN, G, bid);
          pg8::EpiWin E{(bf16_t*)(ws + WS_Q), (bf16_t*)(ws + WS_K), (bf16_t*)(ws + WS_G1), (bf16_t*)(ws + WS_U), (bf16_t*)(ws + WS_SGP), (const float*)(ws + WS_ROPE)};
          pg8::gemm_phase<pg8::EpiWin, pg8::StaticOrder, true, true>(lds, g, S, E); }
#endif
#if PH & 4
        _Pragma("unroll 1") for (int rep = 0; rep < GA_REP; ++rep)
        { FRESH_IDS unsigned char* ws = arg_ws();
          pg8::Gemm g{(bf16_t*)(ws + WS_WVT), (bf16_t*)(ws + WS_HM), DM, MTOK, DM}; pg8::StaticOrder S; S.init(DM, MTOK, G, bid);
          pg8::EpiBf<0> E{(bf16_t*)(ws + WS_VT), (size_t)MTOK};
          pg8::gemm_phase<pg8::EpiBf<0>, pg8::StaticOrder, true, true>(lds, g, S, E); }
#endif
        _Pragma("unroll 1") for (int rep = 0; rep < SYNC_REP; ++rep) GRID_BAR();
#if PH & 8
        _Pragma("unroll 1") for (int rep = 0; rep < R1_REP; ++rep)
        { FRESH_IDS unsigned char* ws = arg_ws();
          r1_phase(lds, (const bf16_t*)(ws + WS_K), (const bf16_t*)(ws + WS_VT), (f32x4*)arg_out(), arg_in(5) + l * 8, arg_in(6) + l * 8, G, bid, tid); }
#endif
        _Pragma("unroll 1") for (int rep = 0; rep < SYNC_REP; ++rep) GRID_BAR();
#if PH & 16
        _Pragma("unroll 1") for (int rep = 0; rep < R3_REP; ++rep)
        { FRESH_IDS unsigned char* ws = arg_ws(); int ds = (rep == R3_REP - 1); asm volatile("" : "+s"(ds));
          r3_phase(lds, (const bf16_t*)(ws + WS_Q), (const bf16_t*)(ws + WS_K), (const bf16_t*)(ws + WS_VT), (bf16_t*)(ws + WS_G1), (const bf16_t*)(ws + WS_U), (const bf16_t*)(ws + WS_SGP),
                   (const f32x4*)arg_out(), (u32x4*)((unsigned char*)arg_out() + 96 * MiB) + (size_t)bid * 4096, arg_in(5) + l * 8, arg_in(6) + l * 8, arg_in(7) + l * DM, G, bid, tid, ds); }
#endif
        _Pragma("unroll 1") for (int rep = 0; rep < SYNC_REP; ++rep) GRID_BAR();
#if PH & 32
        _Pragma("unroll 1") for (int rep = 0; rep < GD_REP; ++rep)
        { FRESH_IDS unsigned char* ws = arg_ws();
          pg8::Gemm g{(bf16_t*)(ws + WS_G1), (bf16_t*)(ws + WS_BTO), MTOK, DM, DM}; pg8::StaticOrder S; S.init(MTOK, DM, G, bid);
          pg8::EpiBf<0> E{(bf16_t*)(ws + WS_Y), (size_t)DM};
          pg8::gemm_phase<pg8::EpiBf<0>, pg8::StaticOrder, true, true>(lds, g, S, E); }
#endif
        _Pragma("unroll 1") for (int rep = 0; rep < SYNC_REP; ++rep) GRID_BAR();
        _Pragma("unroll 1") for (int rep = 0; rep < E_REP; ++rep)
        { FRESH_IDS float* out = arg_out(); int ds = (rep == E_REP - 1); asm volatile("" : "+s"(ds));
          (void)out; e_phase(WSB(bf16_t, WS_Y), WSB(bf16_t, WS_HM), WSB(float, WS_RS), arg_in(3) + l * DM, nullptr, gw, NGW, lane, ds); }
        _Pragma("unroll 1") for (int rep = 0; rep < SYNC_REP; ++rep) GRID_BAR();
#if PH & 64
        _Pragma("unroll 1") for (int rep = 0; rep < GF_REP; ++rep)
        { FRESH_IDS unsigned char* ws = arg_ws();
          pg8::Gemm g{(bf16_t*)(ws + WS_HM), (bf16_t*)(ws + WS_BT1), MTOK, DFF, DM}; pg8::StaticOrder S; S.init(MTOK, DFF, G, bid);
          pg8::EpiBf<1> E{(bf16_t*)(ws + WS_F), (size_t)DFF};
          pg8::gemm_phase<pg8::EpiBf<1>, pg8::StaticOrder, true, true>(lds, g, S, E); }
#endif
        _Pragma("unroll 1") for (int rep = 0; rep < SYNC_REP; ++rep) GRID_BAR();
#if PH & 128
        _Pragma("unroll 1") for (int rep = 0; rep < GG_REP; ++rep)
        { FRESH_IDS unsigned char* ws = arg_ws();
          pg8::Gemm g{(bf16_t*)(ws + WS_F), (bf16_t*)(ws + WS_BT2), MTOK, DM, DFF}; pg8::StaticOrder S; S.init(MTOK, DM, G, bid);
          pg8::EpiBf<0> E{(bf16_t*)(ws + WS_Y), (size_t)DM};
          pg8::gemm_phase<pg8::EpiBf<0>, pg8::StaticOrder, true, true>(lds, g, S, E); }
#endif
        _Pragma("unroll 1") for (int rep = 0; rep < SYNC_REP; ++rep) GRID_BAR();
        _Pragma("unroll 1") for (int rep = 0; rep < E_REP; ++rep)
        { FRESH_IDS float* out = arg_out(); int ds = (rep == E_REP - 1); asm volatile("" : "+s"(ds));
          e_phase(WSB(bf16_t, WS_Y), WSB(bf16_t, WS_HM), WSB(float, WS_RS), arg_in(12) + l * DM, l + 1 < DEPTH ? nullptr : out, gw, NGW, lane, ds); }
        if (l + 1 < DEPTH) {
#if PH & 1
            _Pragma("unroll 1") for (int rep = 0; rep < CV_REP; ++rep) { FRESH_IDS convert_layer(l + 1, lds, gw, NGW, wave, lane); }
#endif
            GRID_BAR(); }
    }
}

extern "C" void kernel_launch(void* const* d_in, const int* in_sizes, int n_in, void* d_out, int out_size, void* d_ws, size_t ws_size, hipStream_t stream) {
    static int grid = 0;
    if (grid == 0) {
        if (n_in != 15 || out_size != MTOK * DM || ws_size < WS_END) { fprintf(stderr, "kernel_launch: unexpected shapes (n_in %d, out %d, ws %zu)\n", n_in, out_size, ws_size); grid = -1; return; }
        int dev = 0, cus = 0, per_cu = 0;
        hipGetDevice(&dev); hipDeviceGetAttribute(&cus, hipDeviceAttributeMultiprocessorCount, dev);
        if (hipFuncSetAttribute((const void*)fwd_megakernel, hipFuncAttributeMaxDynamicSharedMemorySize, LDS_BYTES) != hipSuccess) { fprintf(stderr, "kernel_launch: hipFuncSetAttribute failed\n"); grid = -1; return; }
        if (hipOccupancyMaxActiveBlocksPerMultiprocessor(&per_cu, (const void*)fwd_megakernel, 512, LDS_BYTES) != hipSuccess || per_cu < 1) { fprintf(stderr, "kernel_launch: occupancy query failed (%d)\n", per_cu); (void)hipGetLastError(); per_cu = 1; }
        grid = cus * per_cu;
    }
    if (grid < 0) return;
    if (hipMemsetAsync(d_ws, 0, 131072, stream) != hipSuccess) { fprintf(stderr, "kernel_launch: memset of the barrier words failed\n"); return; }
    Params p{};
    for (int i = 0; i < 15; ++i) p.in[i] = (const float*)d_in[i];
    p.out = (float*)d_out; p.ws = (unsigned char*)d_ws;
    void* args[] = {&p};
    hipError_t e = hipLaunchCooperativeKernel((const void*)fwd_megakernel, dim3(grid), dim3(512), args, LDS_BYTES, stream);
    if (e != hipSuccess) fprintf(stderr, "kernel_launch: cooperative launch failed: %s (grid %d)\n", hipGetErrorString(e), grid);
}
```

```cpp
#include <hip/hip_runtime.h>
#include <hip/hip_cooperative_groups.h>
#include <cstdio>
#include <cstdint>
namespace cg = cooperative_groups;
namespace pg8 {
#define PG8_LAS __attribute__((address_space(3)))
typedef unsigned short bf16_t;
typedef short bf16x8 __attribute__((ext_vector_type(8)));
typedef float f32x4 __attribute__((ext_vector_type(4)));
typedef unsigned u32x4 __attribute__((ext_vector_type(4)));
constexpr int BM = 256, BK = 64, HALF = 128, HTB = HALF * BK * 2  , STAGE_BYTES = 8 * HTB, NXCD = 8, WGM = 8;

__host__ __device__ __forceinline__ int lds_byte(int r, int c) { const int st = (r >> 4) * 2 + (c >> 5), rr = r & 15, cc = c & 31, ob = rr * 64 + cc * 2; return st * 1024 + (ob ^ (((ob >> 9) & 1) << 5)); }
__host__ __device__ __forceinline__ void stage_rc(int b, int& R, int& C) { const int st = b / 1024, sb = b % 1024, swz = sb ^ (((sb >> 9) & 1) << 5); R = (st >> 1) * 16 + swz / 64; C = (st & 1) * 32 + (swz % 64) / 2; }
__host__ __device__ __forceinline__ int perm32(int rho) { const int n = rho >> 4, i = rho & 15; return 8 * (i >> 2) + 4 * n + (i & 3); }

struct Unit { int pm, pn; };
struct Gemm { const bf16_t* A; const bf16_t* Bt; int M, N, K; };

struct StaticOrder {
    int nM, nN, nwg, G, c;
    __host__ __device__ void init(int M, int N, int G_, int c_) { nM = M / BM; nN = N / BM; nwg = nM * nN; G = G_; c = c_; }
    __host__ __device__ bool next(int i, Unit& u) const {
        const long L = (long)i * G + c; if (L >= nwg) return false;
        int wgid = (int)L; { const int q = nwg / NXCD, r = nwg % NXCD, xcd = wgid % NXCD, off = wgid / NXCD; wgid = (xcd < r ? xcd * (q + 1) : r * (q + 1) + (xcd - r) * q) + off; }
        const int nig = WGM * nN, gid = wgid / nig, fm = gid * WGM, gsz = (nM - fm) < WGM ? (nM - fm) : WGM;
        u.pm = fm + ((wgid % nig) % gsz); u.pn = (wgid % nig) / gsz; return true;
    }
    __device__ __forceinline__ void a_ready(const Unit&) const {}
    __device__ __forceinline__ void done(const Unit&) const {}
};

typedef float f32x2 __attribute__((ext_vector_type(2)));
typedef __bf16 bf2_t __attribute__((ext_vector_type(2)));
__device__ __forceinline__ unsigned pk(float lo, float hi) { f32x2 v = {lo, hi}; bf2_t b = __builtin_convertvector(v, bf2_t); return __builtin_bit_cast(unsigned, b); }
__device__ __forceinline__ float sigm(float x) { return __builtin_amdgcn_rcpf(1.0f + __expf(-x)); }

template <int ACT  > struct EpiBf {
    static constexpr bool PERM = true, AFTER_DRAIN = false;
    bf16_t* O; size_t ldc;
    __device__ __forceinline__ void operator()(const f32x4 (&acc)[2][2][4][2], const Unit& u, int wr, int wc, int fr, int fq) const {
        const int row0 = u.pm * BM + wr * 64 + fr; const int col0 = u.pn * BM + wc * 32 + 8 * fq;
#pragma unroll
        for (int ai = 0; ai < 2; ++ai)
#pragma unroll
            for (int m = 0; m < 4; ++m) { bf16_t* rowp = O + (size_t)(row0 + ai * HALF + m * 16) * ldc + col0;
#pragma unroll
                for (int bj = 0; bj < 2; ++bj) { f32x4 v0 = acc[ai][bj][m][0], v1 = acc[ai][bj][m][1];
                    if (ACT == 1) {
#pragma unroll
                        for (int j = 0; j < 4; ++j) { const float a = fmaxf(v0[j], 0.f), b = fmaxf(v1[j], 0.f); v0[j] = a * a; v1[j] = b * b; } }
                    u32x4 w; w.x = pk(v0[0], v0[1]); w.y = pk(v0[2], v0[3]); w.z = pk(v1[0], v1[1]); w.w = pk(v1[2], v1[3]);
                    if (ACT == 1) __builtin_nontemporal_store(w, (u32x4*)(rowp + bj * HALF)); else *(u32x4*)(rowp + bj * HALF) = w; } }
    }
};

struct EpiWin {
    static constexpr bool PERM = true, AFTER_DRAIN = false;
    bf16_t *Q, *Kb, *G1, *U, *SGP; const float* rope;
    __device__ __forceinline__ void operator()(const f32x4 (&acc)[2][2][4][2], const Unit& u, int wr, int wc, int fr, int fq) const {
        const int pn = u.pn; const int row0 = u.pm * BM + wr * 64 + fr;
        if (pn < 4) {
            bf16_t* dst = pn < 2 ? Q : Kb; const int head = (pn & 1) * 4 + wc;
#pragma unroll
            for (int ai = 0; ai < 2; ++ai)
#pragma unroll
                for (int m = 0; m < 4; ++m) {
                    const int row = row0 + ai * HALF + m * 16; const int pos = row < 16384 ? row : ((row - 16384) & 4095);
                    const float* tp = rope + (size_t)pos * 64 + 8 * fq;
                    const f32x4 c0 = *(const f32x4*)(tp), c1 = *(const f32x4*)(tp + 4), s0 = *(const f32x4*)(tp + 32), s1 = *(const f32x4*)(tp + 36);
                    const f32x4 x1a = acc[ai][0][m][0], x1b = acc[ai][0][m][1], x2a = acc[ai][1][m][0], x2b = acc[ai][1][m][1];
                    const f32x4 o1a = x1a * c0 - x2a * s0, o1b = x1b * c1 - x2b * s1, o2a = x1a * s0 + x2a * c0, o2b = x1b * s1 + x2b * c1;
                    bf16_t* rp = dst + (size_t)row * 512 + head * 64 + 8 * fq;
                    u32x4 w1; w1.x = pk(o1a[0], o1a[1]); w1.y = pk(o1a[2], o1a[3]); w1.z = pk(o1b[0], o1b[1]); w1.w = pk(o1b[2], o1b[3]);
                    u32x4 w2; w2.x = pk(o2a[0], o2a[1]); w2.y = pk(o2a[2], o2a[3]); w2.z = pk(o2b[0], o2b[1]); w2.w = pk(o2b[2], o2b[3]);
                    *(u32x4*)rp = w1; *(u32x4*)(rp + 32) = w2; }
        } else if (pn < 12) {
            const int colb = (pn - 4) * 128 + wc * 32 + 8 * fq;
#pragma unroll
            for (int ai = 0; ai < 2; ++ai)
#pragma unroll
                for (int m = 0; m < 4; ++m) {
                    const int row = row0 + ai * HALF + m * 16; float o[8];
#pragma unroll
                    for (int n = 0; n < 2; ++n)
#pragma unroll
                        for (int j = 0; j < 4; ++j) { const float g = acc[ai][0][m][n][j], gr = acc[ai][1][m][n][j]; o[4 * n + j] = g * __builtin_amdgcn_rcpf((1.0f + __expf(-g)) * (1.0f + __expf(-gr))); }
                    u32x4 w; w.x = pk(o[0], o[1]); w.y = pk(o[2], o[3]); w.z = pk(o[4], o[5]); w.w = pk(o[6], o[7]);
                    __builtin_nontemporal_store(w, (u32x4*)(G1 + (size_t)row * 1024 + colb)); }
        } else {
            const bool sg = pn >= 16; bf16_t* dst = sg ? SGP : U; const int col0 = ((pn - 12) & 3) * BM + wc * 32 + 8 * fq;
#pragma unroll
            for (int ai = 0; ai < 2; ++ai)
#pragma unroll
                for (int m = 0; m < 4; ++m) { bf16_t* rowp = dst + (size_t)(row0 + ai * HALF + m * 16) * 1024 + col0;
#pragma unroll
                    for (int bj = 0; bj < 2; ++bj) { f32x4 v0 = acc[ai][bj][m][0], v1 = acc[ai][bj][m][1];
                        if (sg) {
#pragma unroll
                            for (int j = 0; j < 4; ++j) { v0[j] = sigm(v0[j]); v1[j] = sigm(v1[j]); } }
                        u32x4 w; w.x = pk(v0[0], v0[1]); w.y = pk(v0[2], v0[3]); w.z = pk(v1[0], v1[1]); w.w = pk(v1[2], v1[3]);
                        __builtin_nontemporal_store(w, (u32x4*)(rowp + bj * HALF)); } }
        }
    }
};

template <class Epi, class Sched, bool ALIGN_EPI = false, bool SP2 = false>
__device__ __forceinline__ void gemm_phase(PG8_LAS unsigned char* lds, const Gemm g, const Sched& S, const Epi& E) {
    int tid_l = threadIdx.x; asm volatile("" : "+v"(tid_l)); const int tid = tid_l, wid = __builtin_amdgcn_readfirstlane(tid >> 6), lane = tid & 63, wr = wid >> 2, wc = wid & 3, fr = lane & 15, fq = lane >> 4;
    const int K = g.K, nt = K / BK;
    unsigned voffA[2], voffB[2];
#pragma unroll
    for (int i = 0; i < 2; ++i) { int R, C; stage_rc(tid * 16 + i * 8192, R, C); const int Rb = Epi::PERM ? ((R & ~31) + perm32(R & 31)) : R;
        voffA[i] = (unsigned)(R * K + C) * 2u; voffB[i] = (unsigned)(Rb * K + C) * 2u; }
    const size_t kstep = (size_t)(BK * 2);
    const size_t hstep = (size_t)HALF * K * 2;
    const size_t tstep = 2 * hstep;
    const unsigned ldsw = (unsigned)wid * 1024u;
    const int aoff = lds_byte(wr * 64 + fr, fq * 8), boff = lds_byte(wc * 32 + fr, fq * 8);
#define PG8_SA(b, h) (((b) * 2 + (h)) * HTB)
#define PG8_SB(b, h) ((4 + (b) * 2 + (h)) * HTB)
#define PG8_STAGE(bufoff, gbase, voff) do { _Pragma("unroll") for (int _i = 0; _i < 2; ++_i) \
        __builtin_amdgcn_global_load_lds((const unsigned*)((const char*)(gbase) + (voff)[_i]), (PG8_LAS unsigned*)(lds + (bufoff) + ldsw + _i * 8192), 16, 0, 0); } while (0)
#define PG8_LDA(dst, b, h) do { _Pragma("unroll") for (int m = 0; m < 4; ++m) _Pragma("unroll") for (int k = 0; k < 2; ++k) dst[m][k] = *(const PG8_LAS bf16x8*)(lds + PG8_SA(b, h) + aoff + m * 2048 + k * 1024); } while (0)
#define PG8_LDB(dst, b, h) do { _Pragma("unroll") for (int n = 0; n < 2; ++n) _Pragma("unroll") for (int k = 0; k < 2; ++k) dst[n][k] = *(const PG8_LAS bf16x8*)(lds + PG8_SB(b, h) + boff + n * 2048 + k * 1024); } while (0)
#define PG8_MMA(ai, bj, At, Bt) do { __builtin_amdgcn_s_setprio(1); _Pragma("unroll") for (int m = 0; m < 4; ++m) _Pragma("unroll") for (int n = 0; n < 2; ++n) _Pragma("unroll") for (int k = 0; k < 2; ++k) \
        acc[ai][bj][m][n] = __builtin_amdgcn_mfma_f32_16x16x32_bf16(Bt[n][k], At[m][k], acc[ai][bj][m][n], 0, 0, 0); __builtin_amdgcn_s_setprio(0); } while (0)
#define PG8_WAIT_V(n) asm volatile("s_waitcnt vmcnt(" #n ")" ::: "memory")
#define PG8_WAIT_L(n) asm volatile("s_waitcnt lgkmcnt(" #n ")" ::: "memory")
#define PG8_BAR __builtin_amdgcn_s_barrier()
#define PG8_SCHED __builtin_amdgcn_sched_barrier(0)
    Unit cur, nxt; int ui = 0;
    if (!S.next(0, cur)) return;
    f32x4 acc[2][2][4][2];
#pragma unroll
    for (int a = 0; a < 2; ++a)
#pragma unroll
        for (int b = 0; b < 2; ++b)
#pragma unroll
            for (int m = 0; m < 4; ++m)
#pragma unroll
                for (int n = 0; n < 2; ++n) acc[a][b][m][n] = (f32x4){0.f, 0.f, 0.f, 0.f};
    bf16x8 At[4][2], B0[2][2], B1[2][2];
    const char* cA = (const char*)g.A + (size_t)cur.pm * tstep; const char* cB = (const char*)g.Bt + (size_t)cur.pn * tstep;
    S.a_ready(cur);
    if constexpr (SP2) {
        PG8_STAGE(PG8_SB(0, 0), cB, voffB); PG8_STAGE(PG8_SB(0, 1), cB + hstep, voffB); PG8_STAGE(PG8_SA(0, 0), cA, voffA); PG8_STAGE(PG8_SA(0, 1), cA + hstep, voffA);
        if (wr == 1) PG8_BAR;
        PG8_WAIT_V(2); PG8_BAR;
        PG8_STAGE(PG8_SB(1, 0), cB + kstep, voffB); PG8_STAGE(PG8_SA(1, 0), cA + kstep, voffA); PG8_STAGE(PG8_SB(1, 1), cB + hstep + kstep, voffB);
        PG8_WAIT_V(6); PG8_BAR;
    } else {
        PG8_STAGE(PG8_SB(0, 0), cB, voffB); PG8_STAGE(PG8_SA(0, 0), cA, voffA); PG8_STAGE(PG8_SB(0, 1), cB + hstep, voffB); PG8_STAGE(PG8_SA(0, 1), cA + hstep, voffA);
        if (wr == 1) PG8_BAR;
        PG8_WAIT_V(4); PG8_BAR;
        PG8_STAGE(PG8_SB(1, 0), cB + kstep, voffB); PG8_STAGE(PG8_SA(1, 0), cA + kstep, voffA); PG8_STAGE(PG8_SB(1, 1), cB + hstep + kstep, voffB);
        PG8_WAIT_V(6); PG8_BAR;
    }
    for (;;) {
        const bool has_next = S.next(ui + 1, nxt);
        const char* nA = has_next ? (const char*)g.A + (size_t)nxt.pm * tstep : cA; const char* nB = has_next ? (const char*)g.Bt + (size_t)nxt.pn * tstep : cB;
        for (int t = 0; t < nt; t += 2) {
            const bool last = (t == nt - 2);
            const char* a1 = cA + (size_t)(t + 1) * kstep;
            const char* a2 = last ? nA : cA + (size_t)(t + 2) * kstep; const char* b2 = last ? nB : cB + (size_t)(t + 2) * kstep;
            const char* a3 = a2 + kstep; const char* b3 = b2 + kstep;
            if (last && has_next) S.a_ready(nxt);
            if constexpr (SP2) {
            PG8_LDB(B0, 0, 0); PG8_LDB(B1, 0, 1); PG8_SCHED; PG8_LDA(At, 0, 0); PG8_STAGE(PG8_SA(1, 1), a1 + hstep, voffA);
            PG8_WAIT_V(8); PG8_WAIT_L(0); PG8_BAR; PG8_MMA(0, 0, At, B0); PG8_MMA(0, 1, At, B1); PG8_BAR; PG8_SCHED;
            PG8_LDA(At, 0, 1); PG8_STAGE(PG8_SB(0, 0), b2, voffB); PG8_STAGE(PG8_SB(0, 1), b2 + hstep, voffB); PG8_STAGE(PG8_SA(0, 0), a2, voffA);
            PG8_WAIT_V(8); PG8_WAIT_L(0); PG8_BAR; PG8_MMA(1, 0, At, B0); PG8_MMA(1, 1, At, B1); PG8_BAR; PG8_SCHED;
            PG8_LDB(B0, 1, 0); PG8_LDB(B1, 1, 1); PG8_SCHED; PG8_LDA(At, 1, 0); PG8_STAGE(PG8_SA(0, 1), a2 + hstep, voffA);
            PG8_WAIT_V(8); PG8_WAIT_L(0); PG8_BAR; PG8_MMA(0, 0, At, B0); PG8_MMA(0, 1, At, B1); PG8_BAR; PG8_SCHED;
            PG8_LDA(At, 1, 1); PG8_STAGE(PG8_SB(1, 0), b3, voffB); PG8_STAGE(PG8_SB(1, 1), b3 + hstep, voffB); PG8_STAGE(PG8_SA(1, 0), a3, voffA);
            PG8_WAIT_V(8); PG8_WAIT_L(0); PG8_BAR; PG8_MMA(1, 0, At, B0); PG8_MMA(1, 1, At, B1); PG8_BAR; PG8_SCHED;
            } else {
            PG8_LDB(B0, 0, 0); PG8_SCHED; PG8_LDA(At, 0, 0); PG8_STAGE(PG8_SA(1, 1), a1 + hstep, voffA);
            PG8_WAIT_L(8); PG8_BAR; PG8_WAIT_L(0); PG8_MMA(0, 0, At, B0); PG8_BAR; PG8_SCHED;
            PG8_LDB(B1, 0, 1); PG8_STAGE(PG8_SB(0, 0), b2, voffB);
            PG8_BAR; PG8_WAIT_L(0); PG8_MMA(0, 1, At, B1); PG8_BAR;
            PG8_LDA(At, 0, 1); PG8_STAGE(PG8_SA(0, 0), a2, voffA);
            PG8_BAR; PG8_WAIT_L(0); PG8_MMA(1, 0, At, B0); PG8_BAR; PG8_SCHED;
            PG8_STAGE(PG8_SB(0, 1), b2 + hstep, voffB);
            PG8_WAIT_V(6); PG8_BAR; PG8_MMA(1, 1, At, B1); PG8_BAR;
            PG8_LDB(B0, 1, 0); PG8_SCHED; PG8_LDA(At, 1, 0); PG8_STAGE(PG8_SA(0, 1), a2 + hstep, voffA);
            PG8_WAIT_L(8); PG8_BAR; PG8_WAIT_L(0); PG8_MMA(0, 0, At, B0); PG8_BAR; PG8_SCHED;
            PG8_LDB(B1, 1, 1); PG8_STAGE(PG8_SB(1, 0), b3, voffB);
            PG8_BAR; PG8_WAIT_L(0); PG8_MMA(0, 1, At, B1); PG8_BAR;
            PG8_LDA(At, 1, 1); PG8_STAGE(PG8_SA(1, 0), a3, voffA);
            PG8_BAR; PG8_WAIT_L(0); PG8_MMA(1, 0, At, B0); PG8_BAR; PG8_SCHED;
            PG8_STAGE(PG8_SB(1, 1), b3 + hstep, voffB);
            PG8_WAIT_V(6); PG8_BAR; PG8_MMA(1, 1, At, B1); PG8_BAR;
            }
        }
        if constexpr (ALIGN_EPI) { if (wr == 0) PG8_BAR; }
        if constexpr (!Epi::AFTER_DRAIN) { E(acc, cur, wr, wc, fr, fq); S.done(cur); }
        if (!has_next) break;
#pragma unroll
        for (int a = 0; a < 2; ++a)
#pragma unroll
            for (int b = 0; b < 2; ++b)
#pragma unroll
                for (int m = 0; m < 4; ++m)
#pragma unroll
                    for (int n = 0; n < 2; ++n) acc[a][b][m][n] = (f32x4){0.f, 0.f, 0.f, 0.f};
        cur = nxt; cA = nA; cB = nB; ++ui;
        if constexpr (ALIGN_EPI) { if (wr == 1) PG8_BAR; }
    }
    PG8_WAIT_V(0);
    if constexpr (!ALIGN_EPI) { if (wr == 0) PG8_BAR; }
    PG8_BAR;
    if constexpr (Epi::AFTER_DRAIN) { E.fused(acc, cur, wr, wc, fr, fq, lds, wid, lane); S.done(cur); }
#undef PG8_SA
#undef PG8_SB
#undef PG8_STAGE
#undef PG8_LDA
#undef PG8_LDB
#undef PG8_MMA
#undef PG8_WAIT_V
#undef PG8_WAIT_L
#undef PG8_BAR
#undef PG8_SCHED
}
}

#define DI __device__ __forceinline__
#define LAS __attribute__((address_space(3)))
typedef unsigned short bf16_t;
typedef short bf16x8 __attribute__((ext_vector_type(8)));
typedef float f32x4 __attribute__((ext_vector_type(4)));
typedef unsigned u32x4 __attribute__((ext_vector_type(4)));
typedef unsigned u32x2 __attribute__((ext_vector_type(2)));
using pg8::pk;
using pg8::sigm;

constexpr int DM = 1024, DEPTH = 4, SEQ_P = 16384, SEQ_S = 4096;
constexpr int MTOK = 81920, DIN = 6144, DFF = 4096, NWIN = 5120;
constexpr int NUNIT_R = 1280;
constexpr size_t MiB = 1u << 20;
constexpr size_t WS_BAR = 65536, WS_ROPE = 1 * MiB, WS_BTIN = 6 * MiB, WS_WVT = 16 * MiB, WS_BTO = 18 * MiB, WS_BT1 = 20 * MiB, WS_BT2 = 28 * MiB;
constexpr size_t WS_HM = 40 * MiB, WS_Q = 200 * MiB, WS_K = 280 * MiB, WS_VT = 360 * MiB, WS_G1 = 520 * MiB, WS_U = 680 * MiB, WS_SGP = 840 * MiB, WS_RS = 1000 * MiB, WS_END = 1001 * MiB;
constexpr size_t WS_Y = WS_Q, WS_F = WS_VT, WS_ST = WS_HM;
constexpr int LDS_BYTES = 147456;
#ifndef PH
#define PH 255
#endif
#ifndef GEMM_REP
#define GEMM_REP 1
#endif
#ifndef R3_REP
#define R3_REP 1
#endif
#ifndef E_REP
#define E_REP 1
#endif
#ifndef R1_REP
#define R1_REP 1
#endif
#ifndef CV_REP
#define CV_REP 1
#endif
#ifndef GA_REP
#define GA_REP 1
#endif
#ifndef GD_REP
#define GD_REP 1
#endif
#ifndef GF_REP
#define GF_REP 1
#endif
#ifndef GG_REP
#define GG_REP 1
#endif
#ifndef SKEW_A
#define SKEW_A 2600u
#endif
#ifndef SKEW_F
#define SKEW_F 2600u
#endif
#ifndef SYNC_REP
#define SYNC_REP 1
#endif
constexpr int L_QS = 0, L_KS = 18432, L_VT = 36864, L_KT = 71680, L_FF = 89088, L_FB = 107520, L_OS = 0, L_US = 36864, L_KT2 = 89088;

__device__ const double ROPE_INV[32] = {1.0, 0.7498942093324559, 0.5623413251903491, 0.4216965034285822, 0.31622776601683794, 0.23713737056616552, 0.1778279410038923, 0.1333521432163324, 0.1, 0.07498942093324558, 0.05623413251903491, 0.042169650342858224, 0.03162277660168379, 0.023713737056616554, 0.01778279410038923, 0.01333521432163324, 0.01, 0.007498942093324558, 0.005623413251903491, 0.004216965034285823, 0.0031622776601683794, 0.0023713737056616554, 0.0017782794100389228, 0.001333521432163324, 0.001, 0.0007498942093324559, 0.0005623413251903491, 0.00042169650342858224, 0.00031622776601683794, 0.00023713737056616554, 0.00017782794100389227, 0.0001333521432163324};

struct Params { const float* in[15]; float* out; unsigned char* ws; };


typedef const __attribute__((address_space(4))) unsigned char* kargp_t;
DI kargp_t kargs() { kargp_t k = (kargp_t)__builtin_amdgcn_kernarg_segment_ptr(); asm volatile("" : "+s"(k)); return k; }
DI const float* arg_in(int i) { return *(const float* const __attribute__((address_space(4)))*)(kargs() + 8 * i); }
DI float* arg_out() { return *(float* const __attribute__((address_space(4)))*)(kargs() + 120); }
DI unsigned char* arg_ws() { return *(unsigned char* const __attribute__((address_space(4)))*)(kargs() + 128); }

DI float bflo(unsigned w) { return __uint_as_float(w << 16); }
DI float bfhi(unsigned w) { return __uint_as_float(w & 0xffff0000u); }
DI float ex2(float x) { return __builtin_amdgcn_exp2f(x); }
DI float wave_sum(float v) {
#pragma unroll
    for (int o = 1; o < 64; o <<= 1) v += __shfl_xor(v, o);
    return v;
}
DI f32x4 mfma16(bf16x8 x, bf16x8 y, f32x4 c) { return __builtin_amdgcn_mfma_f32_16x16x32_bf16(x, y, c, 0, 0, 0); }
DI bf16x8 as_bf(u32x4 v) { return __builtin_bit_cast(bf16x8, v); }
DI float log2_gamma(float x) { return -log1pf(__expf(-x)) * 1.4426950408889634f; }

DI void tr_item(const float* Wsrc, int ldw, int k0, bf16_t* dst, int Kd, const float* gain, float scale, LAS float* scr, int lane) {
    float v[32];
    const float* src = Wsrc + (size_t)(k0 + (lane >> 5)) * ldw + (lane & 31);
#pragma unroll
    for (int i = 0; i < 32; ++i) v[i] = __builtin_nontemporal_load(src + (size_t)(2 * i) * ldw);
#pragma unroll
    for (int i = 0; i < 32; ++i) scr[(2 * i + (lane >> 5)) * 33 + (lane & 31)] = v[i];
    asm volatile("s_waitcnt lgkmcnt(0)" ::: "memory");
    const int c = lane & 7;
    f32x4 ga = {scale, scale, scale, scale}, gb = ga;
    if (gain) { ga = ga * *(const f32x4*)(gain + k0 + 8 * c); gb = gb * *(const f32x4*)(gain + k0 + 8 * c + 4); }
#pragma unroll
    for (int j = 0; j < 4; ++j) { const int n = (lane >> 3) + 8 * j; const LAS float* s = scr + (8 * c) * 33 + n;
        u32x4 o; o.x = pk(s[0 * 33] * ga[0], s[1 * 33] * ga[1]); o.y = pk(s[2 * 33] * ga[2], s[3 * 33] * ga[3]); o.z = pk(s[4 * 33] * gb[0], s[5 * 33] * gb[1]); o.w = pk(s[6 * 33] * gb[2], s[7 * 33] * gb[3]);
        *(u32x4*)(dst + (size_t)n * Kd + k0 + 8 * c) = o; }
    asm volatile("s_waitcnt lgkmcnt(0)" ::: "memory");
}

DI void convert_layer(int l, LAS unsigned char* lds, int gw, int NGW, int wave, int lane) {
    unsigned char* ws = arg_ws();
    LAS float* scr = (LAS float*)(lds + wave * 16384);
    const float* win = arg_in(4) + (size_t)l * DM * DIN; const float* gpre = arg_in(2) + l * DM;
    const float* wout = arg_in(10) + (size_t)l * DM * DM; const float* gmlp = arg_in(11) + l * DM;
    const float* w1 = arg_in(13) + (size_t)l * DM * DFF; const float* w2 = arg_in(14) + (size_t)l * DFF * DM;
    const float* pw = arg_in(8) + (size_t)l * 4 * 256 * 256; const float* psc = arg_in(9) + l * DM;
    bf16_t* BTin = (bf16_t*)(ws + WS_BTIN); bf16_t* WvT = (bf16_t*)(ws + WS_WVT); bf16_t* BTo = (bf16_t*)(ws + WS_BTO);
    bf16_t* BT1 = (bf16_t*)(ws + WS_BT1); bf16_t* BT2 = (bf16_t*)(ws + WS_BT2);
    for (int it = gw; it < 9216; it += NGW) {
        if (it < 2048) {
            const int sg = it >> 4, kb = it & 15; const int slot0 = sg < 96 ? sg * 32 : 4096 + (sg - 96) * 32;
            const int pn = slot0 >> 8, t = slot0 & 255, bj = t >> 7, wcid = (t >> 5) & 3; int src; float sc = 1.f;
            if (pn < 2) src = ((pn & 1) * 4 + wcid) * 64 + 32 * bj;
            else if (pn < 4) { src = 512 + ((pn & 1) * 4 + wcid) * 64 + 32 * bj; sc = 0.125f; }
            else if (pn < 12) src = (bj ? 4096 : 2048) + 128 * (pn - 4) + 32 * wcid;
            else src = 5120 + (slot0 - 4096);
            tr_item(win + src, DIN, 64 * kb, BTin + (size_t)slot0 * DM, DM, gpre, sc, scr, lane);
        } else if (it < 2560) { const int r = it - 2048, nb = r >> 4, kb = r & 15; tr_item(win + 1024 + 32 * nb, DIN, 64 * kb, WvT + (size_t)(32 * nb) * DM, DM, gpre, 1.f, scr, lane);
        } else if (it < 3072) { const int r = it - 2560, nb = r >> 4, kb = r & 15; tr_item(wout + 32 * nb, DM, 64 * kb, BTo + (size_t)(32 * nb) * DM, DM, nullptr, 1.f, scr, lane);
        } else if (it < 5120) { const int r = it - 3072, nb = r >> 4, kb = r & 15; tr_item(w1 + 32 * nb, DFF, 64 * kb, BT1 + (size_t)(32 * nb) * DM, DM, gmlp, 1.f, scr, lane);
        } else if (it < 7168) { const int r = it - 5120, nb = r >> 6, kb = r & 63; tr_item(w2 + 32 * nb, DM, 64 * kb, BT2 + (size_t)(32 * nb) * DFF, DFF, nullptr, 1.f, scr, lane);
        } else {
            const int fi = it - 7168, ng = fi & 15, kg = fi >> 4; const int g = ng >> 2, d = (ng & 3) * 64 + lane, n = 256 * g + d, k0 = 8 * kg;
            const float* pwp = pw + (size_t)g * 65536 + d;
            typedef const __attribute__((address_space(4))) float* cfp_t;
            cfp_t wp = (cfp_t)(win + (size_t)k0 * DIN + 3072 + g * 256);
            float a[8];
#pragma unroll
            for (int kk = 0; kk < 8; ++kk) a[kk] = 0.f;
#pragma unroll 1
            for (int c = 0; c < 256; c += 8) {
                float pv[8];
#pragma unroll
                for (int j = 0; j < 8; ++j) pv[j] = pwp[(c + j) * 256];
#pragma unroll
                for (int kk = 0; kk < 8; ++kk) {
#pragma unroll
                    for (int j = 0; j < 8; ++j) a[kk] += wp[(size_t)kk * DIN + c + j] * pv[j]; }
            }
            const float sn = psc[n];
#pragma unroll
            for (int kk = 0; kk < 8; ++kk) a[kk] *= sn * gpre[k0 + kk];
            u32x4 o; o.x = pk(a[0], a[1]); o.y = pk(a[2], a[3]); o.z = pk(a[4], a[5]); o.w = pk(a[6], a[7]);
            *(u32x4*)(BTin + (size_t)(3072 + n) * DM + k0) = o;
        }
    }
}

DI void e0_phase(const float* xa, const float* xb, bf16_t* XB, float* IS, int gw, int NGW, int lane) {
    for (int m = gw; m < MTOK; m += NGW) {
        const float* xr = m < SEQ_P ? xa + (size_t)m * DM : xb + (size_t)(m - SEQ_P) * DM;
        f32x4 xv[4]; float ss = 0.f;
#pragma unroll
        for (int j = 0; j < 4; ++j) { xv[j] = __builtin_nontemporal_load((const f32x4*)(xr + 4 * lane + 256 * j)); ss += xv[j][0] * xv[j][0] + xv[j][1] * xv[j][1] + xv[j][2] * xv[j][2] + xv[j][3] * xv[j][3]; }
        const float ms = wave_sum(ss) * (1.f / DM) + 1e-6f, r = rsqrtf(ms);
        if (lane == 0) IS[m] = sqrtf(ms);
#pragma unroll
        for (int j = 0; j < 4; ++j) { u32x2 o; o.x = pk(xv[j][0] * r, xv[j][1] * r); o.y = pk(xv[j][2] * r, xv[j][3] * r); *(u32x2*)(XB + (size_t)m * DM + 4 * lane + 256 * j) = o; }
    }
}
DI void e_phase(const bf16_t* Y, bf16_t* XB, float* IS, const float* gpost, float* out, int gw, int NGW, int lane, int do_store) {
    f32x4 g[4];
#pragma unroll
    for (int j = 0; j < 4; ++j) g[j] = *(const f32x4*)(gpost + 4 * lane + 256 * j);
#pragma unroll 1
    for (int m0 = gw; m0 < MTOK; m0 += 2 * NGW) {
        u32x2 xb2[2][4], yb[2][4]; float isv[2]; const int nr = (m0 + NGW < MTOK) ? 2 : 1;
#pragma unroll
        for (int rr = 0; rr < 2; ++rr) { const int m = rr < nr ? m0 + rr * NGW : m0; isv[rr] = IS[m];
#pragma unroll
            for (int j = 0; j < 4; ++j) { yb[rr][j] = __builtin_nontemporal_load((const u32x2*)(Y + (size_t)m * DM + 4 * lane + 256 * j)); xb2[rr][j] = *(const u32x2*)(XB + (size_t)m * DM + 4 * lane + 256 * j); } }
#pragma unroll
        for (int rr = 0; rr < 2; ++rr) { const int m = m0 + rr * NGW;
            f32x4 yv[4], xv[4]; float ss = 0.f;
#pragma unroll
            for (int j = 0; j < 4; ++j) { yv[j] = (f32x4){bflo(yb[rr][j].x), bfhi(yb[rr][j].x), bflo(yb[rr][j].y), bfhi(yb[rr][j].y)}; xv[j] = (f32x4){bflo(xb2[rr][j].x), bfhi(xb2[rr][j].x), bflo(xb2[rr][j].y), bfhi(xb2[rr][j].y)} * isv[rr];
                ss += yv[j][0] * yv[j][0] + yv[j][1] * yv[j][1] + yv[j][2] * yv[j][2] + yv[j][3] * yv[j][3]; }
            const float ry = rsqrtf(wave_sum(ss) * (1.f / DM) + 1e-6f); float s1 = 0.f;
#pragma unroll
            for (int j = 0; j < 4; ++j) { xv[j] = xv[j] + yv[j] * ry * g[j]; s1 += xv[j][0] * xv[j][0] + xv[j][1] * xv[j][1] + xv[j][2] * xv[j][2] + xv[j][3] * xv[j][3]; }
            if (rr < nr) {
                if (out) {
#pragma unroll
                    for (int j = 0; j < 4; ++j) if (do_store) __builtin_nontemporal_store(xv[j], (f32x4*)(out + (size_t)m * DM + 4 * lane + 256 * j));
                } else {
                    const float ms = wave_sum(s1) * (1.f / DM) + 1e-6f, r1 = rsqrtf(ms);
                    if (lane == 0 && do_store) IS[m] = sqrtf(ms);
#pragma unroll
                    for (int j = 0; j < 4; ++j) { u32x2 o; o.x = pk(xv[j][0] * r1, xv[j][1] * r1); o.y = pk(xv[j][2] * r1, xv[j][3] * r1); if (do_store) *(u32x2*)(XB + (size_t)m * DM + 4 * lane + 256 * j) = o; }
                }
            }
        }
    }
}

DI void state_mma(f32x4 (&acc)[4], LAS unsigned char* Kt, LAS unsigned char* Vt, int w, int r, int q) {
#pragma unroll
    for (int s4 = 0; s4 < 4; ++s4) {
        const bf16x8 vy = *(const LAS bf16x8*)(Vt + (16 * w + r) * 272 + (32 * s4 + 8 * q) * 2);
#pragma unroll
        for (int dt = 0; dt < 4; ++dt) { const bf16x8 kx = *(const LAS bf16x8*)(Kt + (16 * dt + r) * 272 + (32 * s4 + 8 * q) * 2); acc[dt] = mfma16(kx, vy, acc[dt]); }
    }
}
DI void write_kt(LAS unsigned char* Kt, const u32x4 ka, const u32x4 kb, float za, float zb, int w, int lane) {
#pragma unroll
    for (int e = 0; e < 8; ++e) { const unsigned wa = ka[e >> 1], wb = kb[e >> 1]; const float a = (e & 1) ? bfhi(wa) : bflo(wa), b = (e & 1) ? bfhi(wb) : bflo(wb);
        *(LAS unsigned*)(Kt + (8 * w + e) * 272 + lane * 4) = pk(a * za, b * zb); }
}
DI void load_k(const bf16_t* Kb, int row0, int h, int w, int lane, u32x4& ka, u32x4& kb) {
    const bf16_t* pk0 = Kb + (size_t)(row0 + 2 * lane) * 512 + h * 64 + 8 * w; ka = *(const u32x4*)pk0; kb = *(const u32x4*)(pk0 + 512);
}
DI void load_vt(const bf16_t* VT, int row0, int h, int tid, u32x4 (&vv)[4]) {
#pragma unroll
    for (int it = 0; it < 4; ++it) { const int item = tid + 512 * it, dv = item >> 4, tg = item & 15; vv[it] = *(const u32x4*)(VT + (size_t)(h * 128 + dv) * MTOK + row0 + 8 * tg); }
}
DI void write_vt(LAS unsigned char* Vt, int tid, const u32x4 (&vv)[4]) {
#pragma unroll
    for (int it = 0; it < 4; ++it) { const int item = tid + 512 * it, dv = item >> 4, tg = item & 15; *(LAS u32x4*)(Vt + dv * 272 + tg * 16) = vv[it]; }
}

DI void r1_phase(LAS unsigned char* lds, const bf16_t* Kb, const bf16_t* VT, f32x4* ST, const float* decf, const float* decb, int G, int bid, int tid) {
    const int lane = tid & 63, w = __builtin_amdgcn_readfirstlane(tid >> 6), r = lane & 15, q = lane >> 4;
    LAS unsigned char* Vt = lds + L_VT; LAS unsigned char* Ktf = lds + L_KT; LAS unsigned char* Ktb = lds + L_KT2;
#pragma unroll 1
    for (int u = bid; u < NUNIT_R; u += G) {
        const int seg = u >> 3, h = u & 7;
        const float lf2 = log2_gamma(decf[h]), lb2 = log2_gamma(decb[h]);
        f32x4 accF[4], accB[4];
#pragma unroll
        for (int dt = 0; dt < 4; ++dt) { accF[dt] = (f32x4){0.f, 0.f, 0.f, 0.f}; accB[dt] = (f32x4){0.f, 0.f, 0.f, 0.f}; }
        u32x4 ka, kb, vv[4];
        load_k(Kb, seg * 512, h, w, lane, ka, kb); load_vt(VT, seg * 512, h, tid, vv);
#pragma unroll 1
        for (int c = 0; c < 4; ++c) {
            const float tl = (float)(c * 128 + 2 * lane);
            const float zf0 = ex2((511.f - tl) * lf2), zf1 = ex2((510.f - tl) * lf2), zb0 = ex2(tl * lb2), zb1 = ex2((tl + 1.f) * lb2);
            __syncthreads();
            write_kt(Ktf, ka, kb, zf0, zf1, w, lane); write_kt(Ktb, ka, kb, zb0, zb1, w, lane); write_vt(Vt, tid, vv);
            __syncthreads();
            if (c < 3) { const int row1 = seg * 512 + (c + 1) * 128; load_k(Kb, row1, h, w, lane, ka, kb); load_vt(VT, row1, h, tid, vv); }
            state_mma(accF, Ktf, Vt, w, r, q); state_mma(accB, Ktb, Vt, w, r, q);
        }
#pragma unroll
        for (int dt = 0; dt < 4; ++dt) { ST[((size_t)u * 2 + 0) * 2048 + tid * 4 + dt] = accF[dt]; ST[((size_t)u * 2 + 1) * 2048 + tid * 4 + dt] = accB[dt]; }
    }
}

#define R3_IDS int tid = tid0; asm volatile("" : "+v"(tid)); const int lane = tid & 63, r = lane & 15, q = lane >> 4; (void)r; (void)q; (void)lane;
struct R3Stage { u32x4 kv[2], vv[4], qv[2], bs0, bs1; };
DI void r3_preload(R3Stage& st, const bf16_t* Qb, const bf16_t* Kb, const bf16_t* VT, const u32x4* BSV, int row0, int c, int h, int w, int tid0) {
    R3_IDS
    load_vt(VT, row0, h, tid, st.vv);
#pragma unroll
    for (int it = 0; it < 2; ++it) { const int item = tid + 512 * it, tok = item >> 3, g8 = item & 7; st.qv[it] = *(const u32x4*)(Qb + (size_t)(row0 + tok) * 512 + h * 64 + 8 * g8); st.kv[it] = *(const u32x4*)(Kb + (size_t)(row0 + tok) * 512 + h * 64 + 8 * g8); }
    st.bs0 = __builtin_nontemporal_load(BSV + (c * 512 + tid) * 2); st.bs1 = __builtin_nontemporal_load(BSV + (c * 512 + tid) * 2 + 1);
}
DI void r3_phase(LAS unsigned char* lds, const bf16_t* Qb, const bf16_t* Kb, const bf16_t* VT, bf16_t* G1, const bf16_t* U, const bf16_t* SGP, const f32x4* ST, u32x4* BSV,
                 const float* decf, const float* decb, const float* gn, int G, int bid, int tid0, int do_store) {
    const int w = __builtin_amdgcn_readfirstlane(tid0 >> 6);
    LAS unsigned char* Qs = lds + L_QS; LAS unsigned char* Ks = lds + L_KS; LAS unsigned char* Vt = lds + L_VT; LAS unsigned char* Kt = lds + L_KT;
    LAS unsigned char* Ff = lds + L_FF; LAS unsigned char* Fb = lds + L_FB; LAS unsigned char* Os = lds + L_OS; LAS unsigned char* Us = lds + L_US;
#pragma unroll 1
    for (int u = bid; u < NUNIT_R; u += G) {
        const int seg = u >> 3, h = u & 7;
        const int s_lo = seg < 32 ? 0 : 32 + ((seg - 32) & ~7), s_hi = seg < 32 ? 32 : s_lo + 8;
        const int seqlo = s_lo * 512, seqhi = s_hi * 512;
        const float lf2 = log2_gamma(decf[h]), lb2 = log2_gamma(decb[h]);
        const float cdf = ex2(128.f * lf2), cdb = ex2(128.f * lb2);
        f32x4 accF[4], accB[4];
#pragma unroll
        for (int dt = 0; dt < 4; ++dt) { accF[dt] = (f32x4){0.f, 0.f, 0.f, 0.f}; accB[dt] = (f32x4){0.f, 0.f, 0.f, 0.f}; }
        { R3_IDS
          const int nf = min(seg - s_lo, (int)fminf(83.f / fmaxf(-512.f * lf2, 1e-6f), 64.f) + 1), nb = min(s_hi - 1 - seg, (int)fminf(83.f / fmaxf(-512.f * lb2, 1e-6f), 64.f) + 1);
#pragma unroll 4
          for (int i = 0; i < nf; ++i) { const f32x4* sp = ST + ((size_t)((seg - 1 - i) * 8 + h) * 2 + 0) * 2048 + tid * 4; const float fac = ex2(512.f * lf2 * (float)i);
#pragma unroll
              for (int dt = 0; dt < 4; ++dt) accF[dt] += sp[dt] * fac; }
#pragma unroll 4
          for (int i = 0; i < nb; ++i) { const f32x4* sp = ST + ((size_t)((seg + 1 + i) * 8 + h) * 2 + 1) * 2048 + tid * 4; const float fac = ex2(512.f * lb2 * (float)i);
#pragma unroll
              for (int dt = 0; dt < 4; ++dt) accB[dt] += sp[dt] * fac; } }
        { u32x4 ka, kb, vv[4];
          { R3_IDS load_k(Kb, seg * 512 + 384, h, w, lane, ka, kb); load_vt(VT, seg * 512 + 384, h, tid, vv); }
#pragma unroll 1
          for (int c = 3; c >= 0; --c) {
            R3_IDS
            { u32x4 p0, p1; p0.x = pk(accB[0][0], accB[0][1]); p0.y = pk(accB[0][2], accB[0][3]); p0.z = pk(accB[1][0], accB[1][1]); p0.w = pk(accB[1][2], accB[1][3]);
              p1.x = pk(accB[2][0], accB[2][1]); p1.y = pk(accB[2][2], accB[2][3]); p1.z = pk(accB[3][0], accB[3][1]); p1.w = pk(accB[3][2], accB[3][3]);
              BSV[(c * 512 + tid) * 2] = p0; BSV[(c * 512 + tid) * 2 + 1] = p1; }
            if (c == 0) break;
            const float tj = (float)(2 * lane); const float zb0 = ex2(tj * lb2), zb1 = ex2((tj + 1.f) * lb2);
            __syncthreads();
            write_kt(Kt, ka, kb, zb0, zb1, w, lane); write_vt(Vt, tid, vv);
            __syncthreads();
            if (c > 1) { const int row1 = seg * 512 + (c - 1) * 128; load_k(Kb, row1, h, w, lane, ka, kb); load_vt(VT, row1, h, tid, vv); }
#pragma unroll
            for (int dt = 0; dt < 4; ++dt) accB[dt] *= cdb;
            state_mma(accB, Kt, Vt, w, r, q);
          } }
        const int half = 1 << (h >> 1);
        R3Stage st;
        r3_preload(st, Qb, Kb, VT, BSV, seg * 512, 0, h, w, tid0);
#pragma unroll 1
        for (int c = 0; c < 4; ++c) {
            const int row0 = seg * 512 + c * 128;
            { R3_IDS
              __syncthreads();
              write_vt(Vt, tid, st.vv);
#pragma unroll
              for (int it = 0; it < 2; ++it) { const int item = tid + 512 * it, tok = item >> 3, g8 = item & 7; *(LAS u32x4*)(Qs + tok * 144 + 16 * g8) = st.qv[it]; *(LAS u32x4*)(Ks + tok * 144 + 16 * g8) = st.kv[it]; }
#pragma unroll
              for (int dt = 0; dt < 4; ++dt) {
                u32x2 ff; ff.x = pk(accF[dt][0], accF[dt][1]); ff.y = pk(accF[dt][2], accF[dt][3]);
                *(LAS u32x2*)(Ff + (16 * w + r) * 144 + (16 * dt + 4 * q) * 2) = ff;
                u32x2 fb; fb.x = dt < 2 ? st.bs0[2 * dt] : st.bs1[2 * dt - 4]; fb.y = dt < 2 ? st.bs0[2 * dt + 1] : st.bs1[2 * dt - 3];
                *(LAS u32x2*)(Fb + (16 * w + r) * 144 + (16 * dt + 4 * q) * 2) = fb; }
              __syncthreads(); }
            u32x4 uv[5], g1v[4], sgv[4];
            { R3_IDS
#pragma unroll
              for (int it = 0; it < 5; ++it) { const int item = tid + 512 * it, rr = item >> 4, cgp = item & 15, grow = row0 - 8 + rr; uv[it] = (u32x4){0u, 0u, 0u, 0u};
                if (item < 2304 && grow >= seqlo && grow < seqhi) uv[it] = __builtin_nontemporal_load((const u32x4*)(U + (size_t)grow * DM + h * 128 + 8 * cgp)); }
#pragma unroll
              for (int it = 0; it < 4; ++it) { const int tok = 4 * (tid >> 4) + it, cgp = tid & 15; const size_t goff = (size_t)(row0 + tok) * DM + h * 128 + 8 * cgp;
                g1v[it] = __builtin_nontemporal_load((const u32x4*)(G1 + goff)); sgv[it] = __builtin_nontemporal_load((const u32x4*)(SGP + goff)); } }
            if (c < 3) { R3_IDS
              const float tj = (float)(2 * lane); const float zf0 = ex2((127.f - tj) * lf2), zf1 = ex2((126.f - tj) * lf2);
              const u32x4 ka = *(const LAS u32x4*)(Ks + (2 * lane) * 144 + 16 * w), kb = *(const LAS u32x4*)(Ks + (2 * lane + 1) * 144 + 16 * w);
              write_kt(Kt, ka, kb, zf0, zf1, w, lane); }
            f32x4 ao[8]; float rs;
            { R3_IDS
              u32x4 qf[2];
#pragma unroll
              for (int s = 0; s < 2; ++s) qf[s] = *(const LAS u32x4*)(Qs + (16 * w + r) * 144 + (32 * s + 8 * q) * 2);
              f32x4 as[8];
#pragma unroll
              for (int jt = 0; jt < 8; ++jt) { as[jt] = (f32x4){0.f, 0.f, 0.f, 0.f};
#pragma unroll
                for (int s = 0; s < 2; ++s) { const bf16x8 kx = *(const LAS bf16x8*)(Ks + (16 * jt + r) * 144 + (32 * s + 8 * q) * 2); as[jt] = mfma16(kx, as_bf(qf[s]), as[jt]); } }
              const int i = 16 * w + r;
              {
                const int base = i - 4 * q;
                float ef = ex2((float)base * lf2), eb = ex2(-(float)base * lb2);
                const float c16f = ex2(-16.f * lf2), c16b = ex2(16.f * lb2), c1f = ex2(-lf2), c1b = ex2(lb2);
                float tf[4], tb[4]; tf[0] = 1.f; tb[0] = 1.f;
#pragma unroll
                for (int jj = 1; jj < 4; ++jj) { tf[jj] = tf[jj - 1] * c1f; tb[jj] = tb[jj - 1] * c1b; }
#pragma unroll
                for (int jt = 0; jt < 8; ++jt) {
#pragma unroll
                    for (int jj = 0; jj < 4; ++jj) { const int d = base - 16 * jt - jj; as[jt][jj] *= (d >= 0) ? ef * tf[jj] : eb * tb[jj]; }
                    ef *= c16f; eb *= c16b; } }
              u32x4 pf[4];
#pragma unroll
              for (int s2 = 0; s2 < 4; ++s2) { pf[s2].x = pk(as[2 * s2][0], as[2 * s2][1]); pf[s2].y = pk(as[2 * s2][2], as[2 * s2][3]); pf[s2].z = pk(as[2 * s2 + 1][0], as[2 * s2 + 1][1]); pf[s2].w = pk(as[2 * s2 + 1][2], as[2 * s2 + 1][3]); }
              const float xf = ex2((float)(i + 1) * lf2), xb = ex2((float)(128 - i) * lb2);
              u32x4 qff[2], qbb[2];
#pragma unroll
              for (int s = 0; s < 2; ++s)
#pragma unroll
                for (int k = 0; k < 4; ++k) { const float lo = bflo(qf[s][k]), hi = bfhi(qf[s][k]); qff[s][k] = pk(lo * xf, hi * xf); qbb[s][k] = pk(lo * xb, hi * xb); }
              __builtin_amdgcn_sched_barrier(0);
#pragma unroll
              for (int t = 0; t < 8; ++t) { ao[t] = (f32x4){0.f, 0.f, 0.f, 0.f};
#pragma unroll
                for (int s2 = 0; s2 < 4; ++s2) { const u32x2 lo = *(const LAS u32x2*)(Vt + (16 * t + r) * 272 + (32 * s2 + 4 * q) * 2), hi = *(const LAS u32x2*)(Vt + (16 * t + r) * 272 + (32 * s2 + 16 + 4 * q) * 2);
                    const u32x4 vx = {lo.x, lo.y, hi.x, hi.y}; ao[t] = mfma16(as_bf(vx), as_bf(pf[s2]), ao[t]); }
#pragma unroll
                for (int s = 0; s < 2; ++s) { const bf16x8 fx = *(const LAS bf16x8*)(Ff + (16 * t + r) * 144 + (32 * s + 8 * q) * 2); ao[t] = mfma16(fx, as_bf(qff[s]), ao[t]);
                    const bf16x8 bx = *(const LAS bf16x8*)(Fb + (16 * t + r) * 144 + (32 * s + 8 * q) * 2); ao[t] = mfma16(bx, as_bf(qbb[s]), ao[t]); }
                if (t & 1) __builtin_amdgcn_sched_barrier(0); }
              if (c < 3) {
                __syncthreads();
#pragma unroll
                for (int dt = 0; dt < 4; ++dt) accF[dt] *= cdf;
                state_mma(accF, Kt, Vt, w, r, q); }
              __builtin_amdgcn_sched_barrier(0);
              float s1 = 0.f;
#pragma unroll
              for (int t = 0; t < 8; ++t) s1 += (ao[t][0] + ao[t][1]) + (ao[t][2] + ao[t][3]);
              s1 += __shfl_xor(s1, 16); s1 += __shfl_xor(s1, 32);
              const float mu = s1 * (1.f / 128.f); float s2v = 0.f;
#pragma unroll
              for (int t = 0; t < 8; ++t) { ao[t] = ao[t] - mu; s2v += (ao[t][0] * ao[t][0] + ao[t][1] * ao[t][1]) + (ao[t][2] * ao[t][2] + ao[t][3] * ao[t][3]); }
              s2v += __shfl_xor(s2v, 16); s2v += __shfl_xor(s2v, 32);
              rs = rsqrtf(s2v * (1.f / 128.f) + 1e-6f); }
            if (c < 3) r3_preload(st, Qb, Kb, VT, BSV, row0 + 128, c + 1, h, w, tid0);
            __syncthreads();
            { R3_IDS
#pragma unroll
              for (int t = 0; t < 8; ++t) { u32x2 o; o.x = pk(ao[t][0] * rs, ao[t][1] * rs); o.y = pk(ao[t][2] * rs, ao[t][3] * rs); *(LAS u32x2*)(Os + (16 * w + r) * 272 + (16 * t + 4 * q) * 2) = o; }
#pragma unroll
              for (int it = 0; it < 5; ++it) { const int item = tid + 512 * it, rr = item >> 4, cgp = item & 15; if (item < 2304) *(LAS u32x4*)(Us + rr * 272 + cgp * 16) = uv[it]; }
              __syncthreads(); }
            { R3_IDS
              const int cgp = tid & 15, tok0 = 4 * (tid >> 4);
              const f32x4 ga = *(const f32x4*)(gn + h * 128 + 8 * cgp), gb = *(const f32x4*)(gn + h * 128 + 8 * cgp + 4);
              float a8[8];
#pragma unroll
              for (int k = 0; k < 8; ++k) a8[k] = 0.f;
              int lo_c = max(row0 + tok0 - half, seqlo), hi_c = lo_c;
#pragma unroll
              for (int it = 0; it < 4; ++it) {
                const int tok = tok0 + it, grow = row0 + tok;
                const size_t goff = (size_t)grow * DM + h * 128 + 8 * cgp;
                const u32x4 g1 = g1v[it], sg = sgv[it];
                const u32x4 on = *(const LAS u32x4*)(Os + tok * 272 + cgp * 16);
                const int lo = max(grow - half, seqlo), hi = min(grow + half, seqhi);
#pragma unroll 1
                for (; hi_c < hi; ++hi_c) { const u32x4 uw = *(const LAS u32x4*)(Us + (hi_c - row0 + 8) * 272 + cgp * 16);
#pragma unroll
                    for (int k = 0; k < 4; ++k) { a8[2 * k] += bflo(uw[k]); a8[2 * k + 1] += bfhi(uw[k]); } }
#pragma unroll 1
                for (; lo_c < lo; ++lo_c) { const u32x4 uw = *(const LAS u32x4*)(Us + (lo_c - row0 + 8) * 272 + cgp * 16);
#pragma unroll
                    for (int k = 0; k < 4; ++k) { a8[2 * k] -= bflo(uw[k]); a8[2 * k + 1] -= bfhi(uw[k]); } }
                const u32x4 own = *(const LAS u32x4*)(Us + (tok + 8) * 272 + cgp * 16);
                const float inv = 1.f / (float)(hi - lo);
                float mo[8];
#pragma unroll
                for (int k = 0; k < 4; ++k) {
                    const float gl = k < 2 ? ga[2 * k] : gb[2 * k - 4], gh = k < 2 ? ga[2 * k + 1] : gb[2 * k - 3];
                    mo[2 * k] = bflo(g1[k]) * bflo(on[k]) * gl + bflo(sg[k]) * (a8[2 * k] * inv - bflo(own[k]));
                    mo[2 * k + 1] = bfhi(g1[k]) * bfhi(on[k]) * gh + bfhi(sg[k]) * (a8[2 * k + 1] * inv - bfhi(own[k])); }
                u32x4 o; o.x = pk(mo[0], mo[1]); o.y = pk(mo[2], mo[3]); o.z = pk(mo[4], mo[5]); o.w = pk(mo[6], mo[7]);
                if (do_store) *(u32x4*)(G1 + goff) = o;
              } }
        }
    }
}


DI void phase_skew(int bid, unsigned span_ticks) {
    const unsigned d = (unsigned)((bid >> 3) & 31) * span_ticks / 32u;
    const unsigned long long t0 = __builtin_amdgcn_s_memrealtime();
    while ((unsigned)(__builtin_amdgcn_s_memrealtime() - t0) < d) __builtin_amdgcn_s_sleep(16);
}

#define XB_TMO      128
#define XB_XCNT(j)  (256  + 64 * (j))
#define XB_XSUB(j)  (1280 + 64 * (j))
#define XB_XGEN(j)  (2304 + 64 * (j))
#define XB_TOP      3328
#define XB_TOPGEN   3392
#define XCD_BAR_WORDS 3456
#define XB_SPIN_CAP (1u << 18)

__device__ __forceinline__ unsigned xb_ld(unsigned* p)              { return __hip_atomic_load(p, __ATOMIC_RELAXED, __HIP_MEMORY_SCOPE_AGENT); }
__device__ __forceinline__ unsigned xb_add(unsigned* p, unsigned v) { return __hip_atomic_fetch_add(p, v, __ATOMIC_RELAXED, __HIP_MEMORY_SCOPE_AGENT); }
__device__ __forceinline__ unsigned xb_xcc_id() { return (unsigned)__builtin_amdgcn_s_getreg((3 << 11) | 20) & 0xFu; }
#define XB_SPIN(cond, bar) do { unsigned _sp = 0; while (cond) { __builtin_amdgcn_s_sleep(1); \
    if ((++_sp & 255u) == 0u) { if (xb_ld(&(bar)[XB_TMO])) break; if (_sp > XB_SPIN_CAP) { atomicAdd(&(bar)[XB_TMO], 1u); break; } } } } while (0)

struct XcdBarrier {
    unsigned* bar; unsigned x;
    volatile LAS unsigned* st;
};

__device__ __forceinline__ XcdBarrier xcd_barrier_post(unsigned* bar, volatile LAS unsigned* st) {
    XcdBarrier b; b.bar = bar; b.x = xb_xcc_id(); b.st = st;
    if (threadIdx.x == 0) (void)xb_add(&bar[XB_XCNT(b.x)], 1u);
    return b;
}
__device__ __forceinline__ void xcd_barrier_complete(unsigned* bar, unsigned x, unsigned& nloc, unsigned& nx) {
    const unsigned G = gridDim.x * gridDim.y * gridDim.z;
    unsigned sum, cnt, mine, sp = 0u;
    for (;;) {
        sum = 0u; cnt = 0u; mine = 0u;
#pragma unroll
        for (unsigned j = 0; j < 16; ++j) { const unsigned c = xb_ld(&bar[XB_XCNT(j)]); sum += c; cnt += (c > 0u) ? 1u : 0u; mine = (j == x) ? c : mine; }
        if (sum == G) break;
        __builtin_amdgcn_s_sleep(1);
        if ((++sp & 255u) == 0u) { if (xb_ld(&bar[XB_TMO])) break; if (sp > XB_SPIN_CAP) { atomicAdd(&bar[XB_TMO], 1u); break; } }
    }
    nloc = mine > 0u ? mine : 1u; nx = cnt > 0u ? cnt : 1u;
}

__device__ __forceinline__ void xcd_barrier(const XcdBarrier& b) {
    asm volatile("s_waitcnt vmcnt(0)" ::: "memory");
    __syncthreads();
    if (threadIdx.x == 0) {
        unsigned* bar = b.bar;
        __builtin_amdgcn_s_waitcnt(0);
        unsigned nloc = b.st[0], nx = b.st[1];
        if (nloc == 0u) { xcd_barrier_complete(bar, b.x, nloc, nx); b.st[0] = nloc; b.st[1] = nx; }
        const unsigned old = xb_add(&bar[XB_XSUB(b.x)], 1u);
        const unsigned gen = old / nloc;
        if (old + 1u == (gen + 1u) * nloc) {
            __builtin_amdgcn_fence(__ATOMIC_RELEASE, "agent");
            asm volatile("s_waitcnt vmcnt(0)" ::: "memory");
            const unsigned og = xb_add(&bar[XB_TOP], 1u);
            const unsigned tg = og / nx;
            if (og + 1u == (tg + 1u) * nx) xb_add(&bar[XB_TOPGEN], 1u);
            else XB_SPIN(xb_ld(&bar[XB_TOPGEN]) == tg, bar);
            __builtin_amdgcn_fence(__ATOMIC_ACQUIRE, "agent");
            xb_add(&bar[XB_XGEN(b.x)], 1u);
            asm volatile("s_waitcnt vmcnt(0)" ::: "memory");
        } else {
            XB_SPIN(xb_ld(&bar[XB_XGEN(b.x)]) == gen, bar);
            __builtin_amdgcn_fence(__ATOMIC_ACQUIRE, "agent");
            asm volatile("s_waitcnt vmcnt(0)" ::: "memory");
        }
    }
    __syncthreads();
}

__global__ void __launch_bounds__(512, 2) fwd_megakernel(Params p) {
    extern __shared__ __attribute__((aligned(16))) unsigned char lds_raw[];
    LAS unsigned char* lds = (LAS unsigned char*)lds_raw;
    cg::grid_group grid = cg::this_grid();
    volatile LAS unsigned* bst = (volatile LAS unsigned*)(lds + 139264);
    if (threadIdx.x < 2) bst[threadIdx.x] = 0u;
    __syncthreads();
    (void)xcd_barrier_post((unsigned*)(arg_ws() + WS_BAR), bst);
#define GRID_BAR() do { XcdBarrier b_; b_.bar = (unsigned*)(arg_ws() + WS_BAR); b_.x = xb_xcc_id(); b_.st = bst; xcd_barrier(b_); } while (0)
#define FRESH_IDS int tid = threadIdx.x; asm volatile("" : "+v"(tid)); const int lane = tid & 63, wave = __builtin_amdgcn_readfirstlane(tid >> 6); const int G = gridDim.x, bid = blockIdx.x, gw = bid * 8 + wave, NGW = G * 8; (void)lane; (void)gw; (void)NGW;
#define WSB(T, off) ((T*)(arg_ws() + (off)))

    { FRESH_IDS float* rope = WSB(float, WS_ROPE);
      for (int e = bid * 512 + tid; e < SEQ_P * 32; e += G * 512) {
        const int pos = e >> 5, i = e & 31; double rev = (double)pos * ROPE_INV[i] * 0.15915494309189535; rev -= floor(rev); const float rf = (float)rev;
        rope[pos * 64 + i] = __builtin_amdgcn_cosf(rf); rope[pos * 64 + 32 + i] = __builtin_amdgcn_sinf(rf); } }
#if PH & 1
    { FRESH_IDS convert_layer(0, lds, gw, NGW, wave, lane); }
#endif
    { FRESH_IDS e0_phase(arg_in(0), arg_in(1), WSB(bf16_t, WS_HM), WSB(float, WS_RS), gw, NGW, lane); }
    grid.sync();

#pragma unroll 1
    for (int l = 0; l < DEPTH; ++l) {
#if PH & 2
        _Pragma("unroll 1") for (int rep = 0; rep < GA_REP; ++rep)
        { FRESH_IDS unsigned char* ws = arg_ws();
          pg8::Gemm g{(bf16_t*)(ws + WS_HM), (bf16_t*)(ws + WS_BTIN), MTOK, NWIN, DM}; pg8::StaticOrder S; S.init(MTOK, NWIN, G, bid);
          pg8::EpiWin E{(bf16_t*)(ws + WS_Q), (bf16_t*)(ws + WS_K), (bf16_t*)(ws + WS_G1), (bf16_t*)(ws + WS_U), (bf16_t*)(ws + WS_SGP), (const float*)(ws + WS_ROPE)};
          pg8::gemm_phase<pg8::EpiWin, pg8::StaticOrder, true, true>(lds, g, S, E); }
#endif
#if PH & 4
        _Pragma("unroll 1") for (int rep = 0; rep < GA_REP; ++rep)
        { FRESH_IDS unsigned char* ws = arg_ws();
          pg8::Gemm g{(bf16_t*)(ws + WS_WVT), (bf16_t*)(ws + WS_HM), DM, MTOK, DM}; pg8::StaticOrder S; S.init(DM, MTOK, G, bid);
          pg8::EpiBf<0> E{(bf16_t*)(ws + WS_VT), (size_t)MTOK};
          pg8::gemm_phase<pg8::EpiBf<0>, pg8::StaticOrder, true, true>(lds, g, S, E); }
#endif
        _Pragma("unroll 1") for (int rep = 0; rep < SYNC_REP; ++rep) GRID_BAR();
#if PH & 8
        _Pragma("unroll 1") for (int rep = 0; rep < R1_REP; ++rep)
        { FRESH_IDS unsigned char* ws = arg_ws();
          r1_phase(lds, (const bf16_t*)(ws + WS_K), (const bf16_t*)(ws + WS_VT), (f32x4*)arg_out(), arg_in(5) + l * 8, arg_in(6) + l * 8, G, bid, tid); }
#endif
        _Pragma("unroll 1") for (int rep = 0; rep < SYNC_REP; ++rep) GRID_BAR();
#if PH & 16
        _Pragma("unroll 1") for (int rep = 0; rep < R3_REP; ++rep)
        { FRESH_IDS unsigned char* ws = arg_ws(); int ds = (rep == R3_REP - 1); asm volatile("" : "+s"(ds));
          r3_phase(lds, (const bf16_t*)(ws + WS_Q), (const bf16_t*)(ws + WS_K), (const bf16_t*)(ws + WS_VT), (bf16_t*)(ws + WS_G1), (const bf16_t*)(ws + WS_U), (const bf16_t*)(ws + WS_SGP),
                   (const f32x4*)arg_out(), (u32x4*)((unsigned char*)arg_out() + 96 * MiB) + (size_t)bid * 4096, arg_in(5) + l * 8, arg_in(6) + l * 8, arg_in(7) + l * DM, G, bid, tid, ds); }
#endif
        _Pragma("unroll 1") for (int rep = 0; rep < SYNC_REP; ++rep) GRID_BAR();
#if PH & 32
        _Pragma("unroll 1") for (int rep = 0; rep < GD_REP; ++rep)
        { FRESH_IDS unsigned char* ws = arg_ws();
          pg8::Gemm g{(bf16_t*)(ws + WS_G1), (bf16_t*)(ws + WS_BTO), MTOK, DM, DM}; pg8::StaticOrder S; S.init(MTOK, DM, G, bid);
          pg8::EpiBf<0> E{(bf16_t*)(ws + WS_Y), (size_t)DM};
          pg8::gemm_phase<pg8::EpiBf<0>, pg8::StaticOrder, true, true>(lds, g, S, E); }
#endif
        _Pragma("unroll 1") for (int rep = 0; rep < SYNC_REP; ++rep) GRID_BAR();
        _Pragma("unroll 1") for (int rep = 0; rep < E_REP; ++rep)
        { FRESH_IDS float* out = arg_out(); int ds = (rep == E_REP - 1); asm volatile("" : "+s"(ds));
          (void)out; e_phase(WSB(bf16_t, WS_Y), WSB(bf16_t, WS_HM), WSB(float, WS_RS), arg_in(3) + l * DM, nullptr, gw, NGW, lane, ds); }
        _Pragma("unroll 1") for (int rep = 0; rep < SYNC_REP; ++rep) GRID_BAR();
#if PH & 64
        _Pragma("unroll 1") for (int rep = 0; rep < GF_REP; ++rep)
        { FRESH_IDS unsigned char* ws = arg_ws();
          pg8::Gemm g{(bf16_t*)(ws + WS_HM), (bf16_t*)(ws + WS_BT1), MTOK, DFF, DM}; pg8::StaticOrder S; S.init(MTOK, DFF, G, bid);
          pg8::EpiBf<1> E{(bf16_t*)(ws + WS_F), (size_t)DFF};
          pg8::gemm_phase<pg8::EpiBf<1>, pg8::StaticOrder, true, true>(lds, g, S, E); }
#endif
        _Pragma("unroll 1") for (int rep = 0; rep < SYNC_REP; ++rep) GRID_BAR();
#if PH & 128
        _Pragma("unroll 1") for (int rep = 0; rep < GG_REP; ++rep)
        { FRESH_IDS unsigned char* ws = arg_ws();
          pg8::Gemm g{(bf16_t*)(ws + WS_F), (bf16_t*)(ws + WS_BT2), MTOK, DM, DFF}; pg8::StaticOrder S; S.init(MTOK, DM, G, bid);
          pg8::EpiBf<0> E{(bf16_t*)(ws + WS_Y), (size_t)DM};
          pg8::gemm_phase<pg8::EpiBf<0>, pg8::StaticOrder, true, true>(lds, g, S, E); }
#endif
        _Pragma("unroll 1") for (int rep = 0; rep < SYNC_REP; ++rep) GRID_BAR();
        _Pragma("unroll 1") for (int rep = 0; rep < E_REP; ++rep)
        { FRESH_IDS float* out = arg_out(); int ds = (rep == E_REP - 1); asm volatile("" : "+s"(ds));
          e_phase(WSB(bf16_t, WS_Y), WSB(bf16_t, WS_HM), WSB(float, WS_RS), arg_in(12) + l * DM, l + 1 < DEPTH ? nullptr : out, gw, NGW, lane, ds); }
        if (l + 1 < DEPTH) {
#if PH & 1
            _Pragma("unroll 1") for (int rep = 0; rep < CV_REP; ++rep) { FRESH_IDS convert_layer(l + 1, lds, gw, NGW, wave, lane); }
#endif
            GRID_BAR(); }
    }
}

extern "C" void kernel_launch(void* const* d_in, const int* in_sizes, int n_in, void* d_out, int out_size, void* d_ws, size_t ws_size, hipStream_t stream) {
    static int grid = 0;
    if (grid == 0) {
        if (n_in != 15 || out_size != MTOK * DM || ws_size < WS_END) { fprintf(stderr, "kernel_launch: unexpected shapes (n_in %d, out %d, ws %zu)\n", n_in, out_size, ws_size); grid = -1; return; }
        int dev = 0, cus = 0, per_cu = 0;
        hipGetDevice(&dev); hipDeviceGetAttribute(&cus, hipDeviceAttributeMultiprocessorCount, dev);
        if (hipFuncSetAttribute((const void*)fwd_megakernel, hipFuncAttributeMaxDynamicSharedMemorySize, LDS_BYTES) != hipSuccess) { fprintf(stderr, "kernel_launch: hipFuncSetAttribute failed\n"); grid = -1; return; }
        if (hipOccupancyMaxActiveBlocksPerMultiprocessor(&per_cu, (const void*)fwd_megakernel, 512, LDS_BYTES) != hipSuccess || per_cu < 1) { fprintf(stderr, "kernel_launch: occupancy query failed (%d)\n", per_cu); (void)hipGetLastError(); per_cu = 1; }
        grid = cus * per_cu;
    }
    if (grid < 0) return;
    if (hipMemsetAsync(d_ws, 0, 131072, stream) != hipSuccess) { fprintf(stderr, "kernel_launch: memset of the barrier words failed\n"); return; }
    Params p{};
    for (int i = 0; i < 15; ++i) p.in[i] = (const float*)d_in[i];
    p.out = (float*)d_out; p.ws = (unsigned char*)d_ws;
    void* args[] = {&p};
    hipError_t e = hipLaunchCooperativeKernel((const void*)fwd_megakernel, dim3(grid), dim3(512), args, LDS_BYTES, stream);
    if (e != hipSuccess) fprintf(stderr, "kernel_launch: cooperative launch failed: %s (grid %d)\n", hipGetErrorString(e), grid);
}
```

```cpp
#include <hip/hip_runtime.h>
#include <hip/hip_cooperative_groups.h>
#include <cstdio>
#include <cstdint>
namespace cg = cooperative_groups;
namespace pg8 {
#define PG8_LAS __attribute__((address_space(3)))
typedef unsigned short bf16_t;
typedef short bf16x8 __attribute__((ext_vector_type(8)));
typedef float f32x4 __attribute__((ext_vector_type(4)));
typedef unsigned u32x4 __attribute__((ext_vector_type(4)));
constexpr int BM = 256, BK = 64, HALF = 128, HTB = HALF * BK * 2  , STAGE_BYTES = 8 * HTB, NXCD = 8, WGM = 8;

__host__ __device__ __forceinline__ int lds_byte(int r, int c) { const int st = (r >> 4) * 2 + (c >> 5), rr = r & 15, cc = c & 31, ob = rr * 64 + cc * 2; return st * 1024 + (ob ^ (((ob >> 9) & 1) << 5)); }
__host__ __device__ __forceinline__ void stage_rc(int b, int& R, int& C) { const int st = b / 1024, sb = b % 1024, swz = sb ^ (((sb >> 9) & 1) << 5); R = (st >> 1) * 16 + swz / 64; C = (st & 1) * 32 + (swz % 64) / 2; }
__host__ __device__ __forceinline__ int perm32(int rho) { const int n = rho >> 4, i = rho & 15; return 8 * (i >> 2) + 4 * n + (i & 3); }

struct Unit { int pm, pn; };
struct Gemm { const bf16_t* A; const bf16_t* Bt; int M, N, K; };

struct StaticOrder {
    int nM, nN, nwg, G, c;
    __host__ __device__ void init(int M, int N, int G_, int c_) { nM = M / BM; nN = N / BM; nwg = nM * nN; G = G_; c = c_; }
    __host__ __device__ bool next(int i, Unit& u) const {
        const long L = (long)i * G + c; if (L >= nwg) return false;
        int wgid = (int)L; { const int q = nwg / NXCD, r = nwg % NXCD, xcd = wgid % NXCD, off = wgid / NXCD; wgid = (xcd < r ? xcd * (q + 1) : r * (q + 1) + (xcd - r) * q) + off; }
        const int nig = WGM * nN, gid = wgid / nig, fm = gid * WGM, gsz = (nM - fm) < WGM ? (nM - fm) : WGM;
        u.pm = fm + ((wgid % nig) % gsz); u.pn = (wgid % nig) / gsz; return true;
    }
    __device__ __forceinline__ void a_ready(const Unit&) const {}
    __device__ __forceinline__ void done(const Unit&) const {}
};

typedef float f32x2 __attribute__((ext_vector_type(2)));
typedef __bf16 bf2_t __attribute__((ext_vector_type(2)));
__device__ __forceinline__ unsigned pk(float lo, float hi) { f32x2 v = {lo, hi}; bf2_t b = __builtin_convertvector(v, bf2_t); return __builtin_bit_cast(unsigned, b); }
__device__ __forceinline__ float sigm(float x) { return __builtin_amdgcn_rcpf(1.0f + __expf(-x)); }

template <int ACT  > struct EpiBf {
    static constexpr bool PERM = true, AFTER_DRAIN = false;
    bf16_t* O; size_t ldc;
    __device__ __forceinline__ void operator()(const f32x4 (&acc)[2][2][4][2], const Unit& u, int wr, int wc, int fr, int fq) const {
        const int row0 = u.pm * BM + wr * 64 + fr; const int col0 = u.pn * BM + wc * 32 + 8 * fq;
#pragma unroll
        for (int ai = 0; ai < 2; ++ai)
#pragma unroll
            for (int m = 0; m < 4; ++m) { bf16_t* rowp = O + (size_t)(row0 + ai * HALF + m * 16) * ldc + col0;
#pragma unroll
                for (int bj = 0; bj < 2; ++bj) { f32x4 v0 = acc[ai][bj][m][0], v1 = acc[ai][bj][m][1];
                    if (ACT == 1) {
#pragma unroll
                        for (int j = 0; j < 4; ++j) { const float a = fmaxf(v0[j], 0.f), b = fmaxf(v1[j], 0.f); v0[j] = a * a; v1[j] = b * b; } }
                    u32x4 w; w.x = pk(v0[0], v0[1]); w.y = pk(v0[2], v0[3]); w.z = pk(v1[0], v1[1]); w.w = pk(v1[2], v1[3]);
                    if (ACT == 1) __builtin_nontemporal_store(w, (u32x4*)(rowp + bj * HALF)); else *(u32x4*)(rowp + bj * HALF) = w; } }
    }
};

struct EpiWin {
    static constexpr bool PERM = true, AFTER_DRAIN = false;
    bf16_t *Q, *Kb, *G1, *U, *SGP; const float* rope;
    __device__ __forceinline__ void operator()(const f32x4 (&acc)[2][2][4][2], const Unit& u, int wr, int wc, int fr, int fq) const {
        const int pn = u.pn; const int row0 = u.pm * BM + wr * 64 + fr;
        if (pn < 4) {
            bf16_t* dst = pn < 2 ? Q : Kb; const int head = (pn & 1) * 4 + wc;
#pragma unroll
            for (int ai = 0; ai < 2; ++ai)
#pragma unroll
                for (int m = 0; m < 4; ++m) {
                    const int row = row0 + ai * HALF + m * 16; const int pos = row < 16384 ? row : ((row - 16384) & 4095);
                    const float* tp = rope + (size_t)pos * 64 + 8 * fq;
                    const f32x4 c0 = *(const f32x4*)(tp), c1 = *(const f32x4*)(tp + 4), s0 = *(const f32x4*)(tp + 32), s1 = *(const f32x4*)(tp + 36);
                    const f32x4 x1a = acc[ai][0][m][0], x1b = acc[ai][0][m][1], x2a = acc[ai][1][m][0], x2b = acc[ai][1][m][1];
                    const f32x4 o1a = x1a * c0 - x2a * s0, o1b = x1b * c1 - x2b * s1, o2a = x1a * s0 + x2a * c0, o2b = x1b * s1 + x2b * c1;
                    bf16_t* rp = dst + (size_t)row * 512 + head * 64 + 8 * fq;
                    u32x4 w1; w1.x = pk(o1a[0], o1a[1]); w1.y = pk(o1a[2], o1a[3]); w1.z = pk(o1b[0], o1b[1]); w1.w = pk(o1b[2], o1b[3]);
                    u32x4 w2; w2.x = pk(o2a[0], o2a[1]); w2.y = pk(o2a[2], o2a[3]); w2.z = pk(o2b[0], o2b[1]); w2.w = pk(o2b[2], o2b[3]);
                    *(u32x4*)rp = w1; *(u32x4*)(rp + 32) = w2; }
        } else if (pn < 12) {
            const int colb = (pn - 4) * 128 + wc * 32 + 8 * fq;
#pragma unroll
            for (int ai = 0; ai < 2; ++ai)
#pragma unroll
                for (int m = 0; m < 4; ++m) {
                    const int row = row0 + ai * HALF + m * 16; float o[8];
#pragma unroll
                    for (int n = 0; n < 2; ++n)
#pragma unroll
                        for (int j = 0; j < 4; ++j) { const float g = acc[ai][0][m][n][j], gr = acc[ai][1][m][n][j]; o[4 * n + j] = g * __builtin_amdgcn_rcpf((1.0f + __expf(-g)) * (1.0f + __expf(-gr))); }
                    u32x4 w; w.x = pk(o[0], o[1]); w.y = pk(o[2], o[3]); w.z = pk(o[4], o[5]); w.w = pk(o[6], o[7]);
                    __builtin_nontemporal_store(w, (u32x4*)(G1 + (size_t)row * 1024 + colb)); }
        } else {
            const bool sg = pn >= 16; bf16_t* dst = sg ? SGP : U; const int col0 = ((pn - 12) & 3) * BM + wc * 32 + 8 * fq;
#pragma unroll
            for (int ai = 0; ai < 2; ++ai)
#pragma unroll
                for (int m = 0; m < 4; ++m) { bf16_t* rowp = dst + (size_t)(row0 + ai * HALF + m * 16) * 1024 + col0;
#pragma unroll
                    for (int bj = 0; bj < 2; ++bj) { f32x4 v0 = acc[ai][bj][m][0], v1 = acc[ai][bj][m][1];
                        if (sg) {
#pragma unroll
                            for (int j = 0; j < 4; ++j) { v0[j] = sigm(v0[j]); v1[j] = sigm(v1[j]); } }
                        u32x4 w; w.x = pk(v0[0], v0[1]); w.y = pk(v0[2], v0[3]); w.z = pk(v1[0], v1[1]); w.w = pk(v1[2], v1[3]);
                        __builtin_nontemporal_store(w, (u32x4*)(rowp + bj * HALF)); } }
        }
    }
};

template <class Epi, class Sched, bool ALIGN_EPI = false, bool SP2 = false>
__device__ __forceinline__ void gemm_phase(PG8_LAS unsigned char* lds, const Gemm g, const Sched& S, const Epi& E) {
    int tid_l = threadIdx.x; asm volatile("" : "+v"(tid_l)); const int tid = tid_l, wid = __builtin_amdgcn_readfirstlane(tid >> 6), lane = tid & 63, wr = wid >> 2, wc = wid & 3, fr = lane & 15, fq = lane >> 4;
    const int K = g.K, nt = K / BK;
    unsigned voffA[2], voffB[2];
#pragma unroll
    for (int i = 0; i < 2; ++i) { int R, C; stage_rc(tid * 16 + i * 8192, R, C); const int Rb = Epi::PERM ? ((R & ~31) + perm32(R & 31)) : R;
        voffA[i] = (unsigned)(R * K + C) * 2u; voffB[i] = (unsigned)(Rb * K + C) * 2u; }
    const size_t kstep = (size_t)(BK * 2);
    const size_t hstep = (size_t)HALF * K * 2;
    const size_t tstep = 2 * hstep;
    const unsigned ldsw = (unsigned)wid * 1024u;
    const int aoff = lds_byte(wr * 64 + fr, fq * 8), boff = lds_byte(wc * 32 + fr, fq * 8);
#define PG8_SA(b, h) (((b) * 2 + (h)) * HTB)
#define PG8_SB(b, h) ((4 + (b) * 2 + (h)) * HTB)
#define PG8_STAGE(bufoff, gbase, voff) do { _Pragma("unroll") for (int _i = 0; _i < 2; ++_i) \
        __builtin_amdgcn_global_load_lds((const unsigned*)((const char*)(gbase) + (voff)[_i]), (PG8_LAS unsigned*)(lds + (bufoff) + ldsw + _i * 8192), 16, 0, 0); } while (0)
#define PG8_LDA(dst, b, h) do { _Pragma("unroll") for (int m = 0; m < 4; ++m) _Pragma("unroll") for (int k = 0; k < 2; ++k) dst[m][k] = *(const PG8_LAS bf16x8*)(lds + PG8_SA(b, h) + aoff + m * 2048 + k * 1024); } while (0)
#define PG8_LDB(dst, b, h) do { _Pragma("unroll") for (int n = 0; n < 2; ++n) _Pragma("unroll") for (int k = 0; k < 2; ++k) dst[n][k] = *(const PG8_LAS bf16x8*)(lds + PG8_SB(b, h) + boff + n * 2048 + k * 1024); } while (0)
#define PG8_MMA(ai, bj, At, Bt) do { __builtin_amdgcn_s_setprio(1); _Pragma("unroll") for (int m = 0; m < 4; ++m) _Pragma("unroll") for (int n = 0; n < 2; ++n) _Pragma("unroll") for (int k = 0; k < 2; ++k) \
        acc[ai][bj][m][n] = __builtin_amdgcn_mfma_f32_16x16x32_bf16(Bt[n][k], At[m][k], acc[ai][bj][m][n], 0, 0, 0); __builtin_amdgcn_s_setprio(0); } while (0)
#define PG8_WAIT_V(n) asm volatile("s_waitcnt vmcnt(" #n ")" ::: "memory")
#define PG8_WAIT_L(n) asm volatile("s_waitcnt lgkmcnt(" #n ")" ::: "memory")
#define PG8_BAR __builtin_amdgcn_s_barrier()
#define PG8_SCHED __builtin_amdgcn_sched_barrier(0)
    Unit cur, nxt; int ui = 0;
    if (!S.next(0, cur)) return;
    f32x4 acc[2][2][4][2];
#pragma unroll
    for (int a = 0; a < 2; ++a)
#pragma unroll
        for (int b = 0; b < 2; ++b)
#pragma unroll
            for (int m = 0; m < 4; ++m)
#pragma unroll
                for (int n = 0; n < 2; ++n) acc[a][b][m][n] = (f32x4){0.f, 0.f, 0.f, 0.f};
    bf16x8 At[4][2], B0[2][2], B1[2][2];
    const char* cA = (const char*)g.A + (size_t)cur.pm * tstep; const char* cB = (const char*)g.Bt + (size_t)cur.pn * tstep;
    S.a_ready(cur);
    if constexpr (SP2) {
        PG8_STAGE(PG8_SB(0, 0), cB, voffB); PG8_STAGE(PG8_SB(0, 1), cB + hstep, voffB); PG8_STAGE(PG8_SA(0, 0), cA, voffA); PG8_STAGE(PG8_SA(0, 1), cA + hstep, voffA);
        if (wr == 1) PG8_BAR;
        PG8_WAIT_V(2); PG8_BAR;
        PG8_STAGE(PG8_SB(1, 0), cB + kstep, voffB); PG8_STAGE(PG8_SA(1, 0), cA + kstep, voffA); PG8_STAGE(PG8_SB(1, 1), cB + hstep + kstep, voffB);
        PG8_WAIT_V(6); PG8_BAR;
    } else {
        PG8_STAGE(PG8_SB(0, 0), cB, voffB); PG8_STAGE(PG8_SA(0, 0), cA, voffA); PG8_STAGE(PG8_SB(0, 1), cB + hstep, voffB); PG8_STAGE(PG8_SA(0, 1), cA + hstep, voffA);
        if (wr == 1) PG8_BAR;
        PG8_WAIT_V(4); PG8_BAR;
        PG8_STAGE(PG8_SB(1, 0), cB + kstep, voffB); PG8_STAGE(PG8_SA(1, 0), cA + kstep, voffA); PG8_STAGE(PG8_SB(1, 1), cB + hstep + kstep, voffB);
        PG8_WAIT_V(6); PG8_BAR;
    }
    for (;;) {
        const bool has_next = S.next(ui + 1, nxt);
        const char* nA = has_next ? (const char*)g.A + (size_t)nxt.pm * tstep : cA; const char* nB = has_next ? (const char*)g.Bt + (size_t)nxt.pn * tstep : cB;
        for (int t = 0; t < nt; t += 2) {
            const bool last = (t == nt - 2);
            const char* a1 = cA + (size_t)(t + 1) * kstep;
            const char* a2 = last ? nA : cA + (size_t)(t + 2) * kstep; const char* b2 = last ? nB : cB + (size_t)(t + 2) * kstep;
            const char* a3 = a2 + kstep; const char* b3 = b2 + kstep;
            if (last && has_next) S.a_ready(nxt);
            if constexpr (SP2) {
            PG8_LDB(B0, 0, 0); PG8_LDB(B1, 0, 1); PG8_SCHED; PG8_LDA(At, 0, 0); PG8_STAGE(PG8_SA(1, 1), a1 + hstep, voffA);
            PG8_WAIT_V(8); PG8_WAIT_L(0); PG8_BAR; PG8_MMA(0, 0, At, B0); PG8_MMA(0, 1, At, B1); PG8_BAR; PG8_SCHED;
            PG8_LDA(At, 0, 1); PG8_STAGE(PG8_SB(0, 0), b2, voffB); PG8_STAGE(PG8_SB(0, 1), b2 + hstep, voffB); PG8_STAGE(PG8_SA(0, 0), a2, voffA);
            PG8_WAIT_V(8); PG8_WAIT_L(0); PG8_BAR; PG8_MMA(1, 0, At, B0); PG8_MMA(1, 1, At, B1); PG8_BAR; PG8_SCHED;
            PG8_LDB(B0, 1, 0); PG8_LDB(B1, 1, 1); PG8_SCHED; PG8_LDA(At, 1, 0); PG8_STAGE(PG8_SA(0, 1), a2 + hstep, voffA);
            PG8_WAIT_V(8); PG8_WAIT_L(0); PG8_BAR; PG8_MMA(0, 0, At, B0); PG8_MMA(0, 1, At, B1); PG8_BAR; PG8_SCHED;
            PG8_LDA(At, 1, 1); PG8_STAGE(PG8_SB(1, 0), b3, voffB); PG8_STAGE(PG8_SB(1, 1), b3 + hstep, voffB); PG8_STAGE(PG8_SA(1, 0), a3, voffA);
            PG8_WAIT_V(8); PG8_WAIT_L(0); PG8_BAR; PG8_MMA(1, 0, At, B0); PG8_MMA(1, 1, At, B1); PG8_BAR; PG8_SCHED;
            } else {
            PG8_LDB(B0, 0, 0); PG8_SCHED; PG8_LDA(At, 0, 0); PG8_STAGE(PG8_SA(1, 1), a1 + hstep, voffA);
            PG8_WAIT_L(8); PG8_BAR; PG8_WAIT_L(0); PG8_MMA(0, 0, At, B0); PG8_BAR; PG8_SCHED;
            PG8_LDB(B1, 0, 1); PG8_STAGE(PG8_SB(0, 0), b2, voffB);
            PG8_BAR; PG8_WAIT_L(0); PG8_MMA(0, 1, At, B1); PG8_BAR;
            PG8_LDA(At, 0, 1); PG8_STAGE(PG8_SA(0, 0), a2, voffA);
            PG8_BAR; PG8_WAIT_L(0); PG8_MMA(1, 0, At, B0); PG8_BAR; PG8_SCHED;
            PG8_STAGE(PG8_SB(0, 1), b2 + hstep, voffB);
            PG8_WAIT_V(6); PG8_BAR; PG8_MMA(1, 1, At, B1); PG8_BAR;
            PG8_LDB(B0, 1, 0); PG8_SCHED; PG8_LDA(At, 1, 0); PG8_STAGE(PG8_SA(0, 1), a2 + hstep, voffA);
            PG8_WAIT_L(8); PG8_BAR; PG8_WAIT_L(0); PG8_MMA(0, 0, At, B0); PG8_BAR; PG8_SCHED;
            PG8_LDB(B1, 1, 1); PG8_STAGE(PG8_SB(1, 0), b3, voffB);
            PG8_BAR; PG8_WAIT_L(0); PG8_MMA(0, 1, At, B1); PG8_BAR;
            PG8_LDA(At, 1, 1); PG8_STAGE(PG8_SA(1, 0), a3, voffA);
            PG8_BAR; PG8_WAIT_L(0); PG8_MMA(1, 0, At, B0); PG8_BAR; PG8_SCHED;
            PG8_STAGE(PG8_SB(1, 1), b3 + hstep, voffB);
            PG8_WAIT_V(6); PG8_BAR; PG8_MMA(1, 1, At, B1); PG8_BAR;
            }
        }
        if constexpr (ALIGN_EPI) { if (wr == 0) PG8_BAR; }
        if constexpr (!Epi::AFTER_DRAIN) { E(acc, cur, wr, wc, fr, fq); S.done(cur); }
        if (!has_next) break;
#pragma unroll
        for (int a = 0; a < 2; ++a)
#pragma unroll
            for (int b = 0; b < 2; ++b)
#pragma unroll
                for (int m = 0; m < 4; ++m)
#pragma unroll
                    for (int n = 0; n < 2; ++n) acc[a][b][m][n] = (f32x4){0.f, 0.f, 0.f, 0.f};
        cur = nxt; cA = nA; cB = nB; ++ui;
        if constexpr (ALIGN_EPI) { if (wr == 1) PG8_BAR; }
    }
    PG8_WAIT_V(0);
    if constexpr (!ALIGN_EPI) { if (wr == 0) PG8_BAR; }
    PG8_BAR;
    if constexpr (Epi::AFTER_DRAIN) { E.fused(acc, cur, wr, wc, fr, fq, lds, wid, lane); S.done(cur); }
#undef PG8_SA
#undef PG8_SB
#undef PG8_STAGE
#undef PG8_LDA
#undef PG8_LDB
#undef PG8_MMA
#undef PG8_WAIT_V
#undef PG8_WAIT_L
#undef PG8_BAR
#undef PG8_SCHED
}
}

#define DI __device__ __forceinline__
#define LAS __attribute__((address_space(3)))
typedef unsigned short bf16_t;
typedef short bf16x8 __attribute__((ext_vector_type(8)));
typedef float f32x4 __attribute__((ext_vector_type(4)));
typedef unsigned u32x4 __attribute__((ext_vector_type(4)));
typedef unsigned u32x2 __attribute__((ext_vector_type(2)));
using pg8::pk;
using pg8::sigm;

constexpr int DM = 1024, DEPTH = 4, SEQ_P = 16384, SEQ_S = 4096;
constexpr int MTOK = 81920, DIN = 6144, DFF = 4096, NWIN = 5120;
constexpr int NUNIT_R = 1280;
constexpr size_t MiB = 1u << 20;
constexpr size_t WS_BAR = 65536, WS_ROPE = 1 * MiB, WS_BTIN = 6 * MiB, WS_WVT = 16 * MiB, WS_BTO = 18 * MiB, WS_BT1 = 20 * MiB, WS_BT2 = 28 * MiB;
constexpr size_t WS_HM = 40 * MiB, WS_Q = 200 * MiB, WS_K = 280 * MiB, WS_VT = 360 * MiB, WS_G1 = 520 * MiB, WS_U = 680 * MiB, WS_SGP = 840 * MiB, WS_RS = 1000 * MiB, WS_END = 1001 * MiB;
constexpr size_t WS_Y = WS_Q, WS_F = WS_VT, WS_ST = WS_HM;
constexpr int LDS_BYTES = 147456;
#ifndef PH
#define PH 255
#endif
#ifndef GEMM_REP
#define GEMM_REP 1
#endif
#ifndef R3_REP
#define R3_REP 1
#endif
#ifndef E_REP
#define E_REP 1
#endif
#ifndef R1_REP
#define R1_REP 1
#endif
#ifndef CV_REP
#define CV_REP 1
#endif
#ifndef GA_REP
#define GA_REP 1
#endif
#ifndef GD_REP
#define GD_REP 1
#endif
#ifndef GF_REP
#define GF_REP 1
#endif
#ifndef GG_REP
#define GG_REP 1
#endif
#ifndef SKEW_A
#define SKEW_A 2600u
#endif
#ifndef SKEW_F
#define SKEW_F 2600u
#endif
#ifndef SYNC_REP
#define SYNC_REP 1
#endif
constexpr int L_QS = 0, L_KS = 18432, L_VT = 36864, L_KT = 71680, L_FF = 89088, L_FB = 107520, L_OS = 0, L_US = 36864, L_KT2 = 89088;

__device__ const double ROPE_INV[32] = {1.0, 0.7498942093324559, 0.5623413251903491, 0.4216965034285822, 0.31622776601683794, 0.23713737056616552, 0.1778279410038923, 0.1333521432163324, 0.1, 0.07498942093324558, 0.05623413251903491, 0.042169650342858224, 0.03162277660168379, 0.023713737056616554, 0.01778279410038923, 0.01333521432163324, 0.01, 0.007498942093324558, 0.005623413251903491, 0.004216965034285823, 0.0031622776601683794, 0.0023713737056616554, 0.0017782794100389228, 0.001333521432163324, 0.001, 0.0007498942093324559, 0.0005623413251903491, 0.00042169650342858224, 0.00031622776601683794, 0.00023713737056616554, 0.00017782794100389227, 0.0001333521432163324};

struct Params { const float* in[15]; float* out; unsigned char* ws; };


typedef const __attribute__((address_space(4))) unsigned char* kargp_t;
DI kargp_t kargs() { kargp_t k = (kargp_t)__builtin_amdgcn_kernarg_segment_ptr(); asm volatile("" : "+s"(k)); return k; }
DI const float* arg_in(int i) { return *(const float* const __attribute__((address_space(4)))*)(kargs() + 8 * i); }
DI float* arg_out() { return *(float* const __attribute__((address_space(4)))*)(kargs() + 120); }
DI unsigned char* arg_ws() { return *(unsigned char* const __attribute__((address_space(4)))*)(kargs() + 128); }

DI float bflo(unsigned w) { return __uint_as_float(w << 16); }
DI float bfhi(unsigned w) { return __uint_as_float(w & 0xffff0000u); }
DI float ex2(float x) { return __builtin_amdgcn_exp2f(x); }
DI float wave_sum(float v) {
#pragma unroll
    for (int o = 1; o < 64; o <<= 1) v += __shfl_xor(v, o);
    return v;
}
DI f32x4 mfma16(bf16x8 x, bf16x8 y, f32x4 c) { return __builtin_amdgcn_mfma_f32_16x16x32_bf16(x, y, c, 0, 0, 0); }
DI bf16x8 as_bf(u32x4 v) { return __builtin_bit_cast(bf16x8, v); }
DI float log2_gamma(float x) { return -log1pf(__expf(-x)) * 1.4426950408889634f; }

DI void tr_item(const float* Wsrc, int ldw, int k0, bf16_t* dst, int Kd, const float* gain, float scale, LAS float* scr, int lane) {
    float v[32];
    const float* src = Wsrc + (size_t)(k0 + (lane >> 5)) * ldw + (lane & 31);
#pragma unroll
    for (int i = 0; i < 32; ++i) v[i] = __builtin_nontemporal_load(src + (size_t)(2 * i) * ldw);
#pragma unroll
    for (int i = 0; i < 32; ++i) scr[(2 * i + (lane >> 5)) * 33 + (lane & 31)] = v[i];
    asm volatile("s_waitcnt lgkmcnt(0)" ::: "memory");
    const int c = lane & 7;
    f32x4 ga = {scale, scale, scale, scale}, gb = ga;
    if (gain) { ga = ga * *(const f32x4*)(gain + k0 + 8 * c); gb = gb * *(const f32x4*)(gain + k0 + 8 * c + 4); }
#pragma unroll
    for (int j = 0; j < 4; ++j) { const int n = (lane >> 3) + 8 * j; const LAS float* s = scr + (8 * c) * 33 + n;
        u32x4 o; o.x = pk(s[0 * 33] * ga[0], s[1 * 33] * ga[1]); o.y = pk(s[2 * 33] * ga[2], s[3 * 33] * ga[3]); o.z = pk(s[4 * 33] * gb[0], s[5 * 33] * gb[1]); o.w = pk(s[6 * 33] * gb[2], s[7 * 33] * gb[3]);
        *(u32x4*)(dst + (size_t)n * Kd + k0 + 8 * c) = o; }
    asm volatile("s_waitcnt lgkmcnt(0)" ::: "memory");
}

DI void convert_layer(int l, LAS unsigned char* lds, int gw, int NGW, int wave, int lane) {
    unsigned char* ws = arg_ws();
    LAS float* scr = (LAS float*)(lds + wave * 16384);
    const float* win = arg_in(4) + (size_t)l * DM * DIN; const float* gpre = arg_in(2) + l * DM;
    const float* wout = arg_in(10) + (size_t)l * DM * DM; const float* gmlp = arg_in(11) + l * DM;
    const float* w1 = arg_in(13) + (size_t)l * DM * DFF; const float* w2 = arg_in(14) + (size_t)l * DFF * DM;
    const float* pw = arg_in(8) + (size_t)l * 4 * 256 * 256; const float* psc = arg_in(9) + l * DM;
    bf16_t* BTin = (bf16_t*)(ws + WS_BTIN); bf16_t* WvT = (bf16_t*)(ws + WS_WVT); bf16_t* BTo = (bf16_t*)(ws + WS_BTO);
    bf16_t* BT1 = (bf16_t*)(ws + WS_BT1); bf16_t* BT2 = (bf16_t*)(ws + WS_BT2);
    for (int it = gw; it < 9216; it += NGW) {
        if (it < 2048) {
            const int sg = it >> 4, kb = it & 15; const int slot0 = sg < 96 ? sg * 32 : 4096 + (sg - 96) * 32;
            const int pn = slot0 >> 8, t = slot0 & 255, bj = t >> 7, wcid = (t >> 5) & 3; int src; float sc = 1.f;
            if (pn < 2) src = ((pn & 1) * 4 + wcid) * 64 + 32 * bj;
            else if (pn < 4) { src = 512 + ((pn & 1) * 4 + wcid) * 64 + 32 * bj; sc = 0.125f; }
            else if (pn < 12) src = (bj ? 4096 : 2048) + 128 * (pn - 4) + 32 * wcid;
            else src = 5120 + (slot0 - 4096);
            tr_item(win + src, DIN, 64 * kb, BTin + (size_t)slot0 * DM, DM, gpre, sc, scr, lane);
        } else if (it < 2560) { const int r = it - 2048, nb = r >> 4, kb = r & 15; tr_item(win + 1024 + 32 * nb, DIN, 64 * kb, WvT + (size_t)(32 * nb) * DM, DM, gpre, 1.f, scr, lane);
        } else if (it < 3072) { const int r = it - 2560, nb = r >> 4, kb = r & 15; tr_item(wout + 32 * nb, DM, 64 * kb, BTo + (size_t)(32 * nb) * DM, DM, nullptr, 1.f, scr, lane);
        } else if (it < 5120) { const int r = it - 3072, nb = r >> 4, kb = r & 15; tr_item(w1 + 32 * nb, DFF, 64 * kb, BT1 + (size_t)(32 * nb) * DM, DM, gmlp, 1.f, scr, lane);
        } else if (it < 7168) { const int r = it - 5120, nb = r >> 6, kb = r & 63; tr_item(w2 + 32 * nb, DM, 64 * kb, BT2 + (size_t)(32 * nb) * DFF, DFF, nullptr, 1.f, scr, lane);
        } else {
            const int fi = it - 7168, ng = fi & 15, kg = fi >> 4; const int g = ng >> 2, d = (ng & 3) * 64 + lane, n = 256 * g + d, k0 = 8 * kg;
            const float* pwp = pw + (size_t)g * 65536 + d;
            typedef const __attribute__((address_space(4))) float* cfp_t;
            cfp_t wp = (cfp_t)(win + (size_t)k0 * DIN + 3072 + g * 256);
            float a[8];
#pragma unroll
            for (int kk = 0; kk < 8; ++kk) a[kk] = 0.f;
#pragma unroll 1
            for (int c = 0; c < 256; c += 8) {
                float pv[8];
#pragma unroll
                for (int j = 0; j < 8; ++j) pv[j] = pwp[(c + j) * 256];
#pragma unroll
                for (int kk = 0; kk < 8; ++kk) {
#pragma unroll
                    for (int j = 0; j < 8; ++j) a[kk] += wp[(size_t)kk * DIN + c + j] * pv[j]; }
            }
            const float sn = psc[n];
#pragma unroll
            for (int kk = 0; kk < 8; ++kk) a[kk] *= sn * gpre[k0 + kk];
            u32x4 o; o.x = pk(a[0], a[1]); o.y = pk(a[2], a[3]); o.z = pk(a[4], a[5]); o.w = pk(a[6], a[7]);
            *(u32x4*)(BTin + (size_t)(3072 + n) * DM + k0) = o;
        }
    }
}

DI void e0_phase(const float* xa, const float* xb, bf16_t* XB, float* IS, int gw, int NGW, int lane) {
    for (int m = gw; m < MTOK; m += NGW) {
        const float* xr = m < SEQ_P ? xa + (size_t)m * DM : xb + (size_t)(m - SEQ_P) * DM;
        f32x4 xv[4]; float ss = 0.f;
#pragma unroll
        for (int j = 0; j < 4; ++j) { xv[j] = __builtin_nontemporal_load((const f32x4*)(xr + 4 * lane + 256 * j)); ss += xv[j][0] * xv[j][0] + xv[j][1] * xv[j][1] + xv[j][2] * xv[j][2] + xv[j][3] * xv[j][3]; }
        const float ms = wave_sum(ss) * (1.f / DM) + 1e-6f, r = rsqrtf(ms);
        if (lane == 0) IS[m] = sqrtf(ms);
#pragma unroll
        for (int j = 0; j < 4; ++j) { u32x2 o; o.x = pk(xv[j][0] * r, xv[j][1] * r); o.y = pk(xv[j][2] * r, xv[j][3] * r); *(u32x2*)(XB + (size_t)m * DM + 4 * lane + 256 * j) = o; }
    }
}
DI void e_phase(const bf16_t* Y, bf16_t* XB, float* IS, const float* gpost, float* out, int gw, int NGW, int lane, int do_store) {
    f32x4 g[4];
#pragma unroll
    for (int j = 0; j < 4; ++j) g[j] = *(const f32x4*)(gpost + 4 * lane + 256 * j);
#pragma unroll 1
    for (int m0 = gw; m0 < MTOK; m0 += 2 * NGW) {
        u32x2 xb2[2][4], yb[2][4]; float isv[2]; const int nr = (m0 + NGW < MTOK) ? 2 : 1;
#pragma unroll
        for (int rr = 0; rr < 2; ++rr) { const int m = rr < nr ? m0 + rr * NGW : m0; isv[rr] = IS[m];
#pragma unroll
            for (int j = 0; j < 4; ++j) { yb[rr][j] = __builtin_nontemporal_load((const u32x2*)(Y + (size_t)m * DM + 4 * lane + 256 * j)); xb2[rr][j] = *(const u32x2*)(XB + (size_t)m * DM + 4 * lane + 256 * j); } }
#pragma unroll
        for (int rr = 0; rr < 2; ++rr) { const int m = m0 + rr * NGW;
            f32x4 yv[4], xv[4]; float ss = 0.f;
#pragma unroll
            for (int j = 0; j < 4; ++j) { yv[j] = (f32x4){bflo(yb[rr][j].x), bfhi(yb[rr][j].x), bflo(yb[rr][j].y), bfhi(yb[rr][j].y)}; xv[j] = (f32x4){bflo(xb2[rr][j].x), bfhi(xb2[rr][j].x), bflo(xb2[rr][j].y), bfhi(xb2[rr][j].y)} * isv[rr];
                ss += yv[j][0] * yv[j][0] + yv[j][1] * yv[j][1] + yv[j][2] * yv[j][2] + yv[j][3] * yv[j][3]; }
            const float ry = rsqrtf(wave_sum(ss) * (1.f / DM) + 1e-6f); float s1 = 0.f;
#pragma unroll
            for (int j = 0; j < 4; ++j) { xv[j] = xv[j] + yv[j] * ry * g[j]; s1 += xv[j][0] * xv[j][0] + xv[j][1] * xv[j][1] + xv[j][2] * xv[j][2] + xv[j][3] * xv[j][3]; }
            if (rr < nr) {
                if (out) {
#pragma unroll
                    for (int j = 0; j < 4; ++j) if (do_store) __builtin_nontemporal_store(xv[j], (f32x4*)(out + (size_t)m * DM + 4 * lane + 256 * j));
                } else {
                    const float ms = wave_sum(s1) * (1.f / DM) + 1e-6f, r1 = rsqrtf(ms);
                    if (lane == 0 && do_store) IS[m] = sqrtf(ms);
#pragma unroll
                    for (int j = 0; j < 4; ++j) { u32x2 o; o.x = pk(xv[j][0] * r1, xv[j][1] * r1); o.y = pk(xv[j][2] * r1, xv[j][3] * r1); if (do_store) *(u32x2*)(XB + (size_t)m * DM + 4 * lane + 256 * j) = o; }
                }
            }
        }
    }
}

DI void state_mma(f32x4 (&acc)[4], LAS unsigned char* Kt, LAS unsigned char* Vt, int w, int r, int q) {
#pragma unroll
    for (int s4 = 0; s4 < 4; ++s4) {
        const bf16x8 vy = *(const LAS bf16x8*)(Vt + (16 * w + r) * 272 + (32 * s4 + 8 * q) * 2);
#pragma unroll
        for (int dt = 0; dt < 4; ++dt) { const bf16x8 kx = *(const LAS bf16x8*)(Kt + (16 * dt + r) * 272 + (32 * s4 + 8 * q) * 2); acc[dt] = mfma16(kx, vy, acc[dt]); }
    }
}
DI void write_kt(LAS unsigned char* Kt, const u32x4 ka, const u32x4 kb, float za, float zb, int w, int lane) {
#pragma unroll
    for (int e = 0; e < 8; ++e) { const unsigned wa = ka[e >> 1], wb = kb[e >> 1]; const float a = (e & 1) ? bfhi(wa) : bflo(wa), b = (e & 1) ? bfhi(wb) : bflo(wb);
        *(LAS unsigned*)(Kt + (8 * w + e) * 272 + lane * 4) = pk(a * za, b * zb); }
}
DI void load_k(const bf16_t* Kb, int row0, int h, int w, int lane, u32x4& ka, u32x4& kb) {
    const bf16_t* pk0 = Kb + (size_t)(row0 + 2 * lane) * 512 + h * 64 + 8 * w; ka = *(const u32x4*)pk0; kb = *(const u32x4*)(pk0 + 512);
}
DI void load_vt(const bf16_t* VT, int row0, int h, int tid, u32x4 (&vv)[4]) {
#pragma unroll
    for (int it = 0; it < 4; ++it) { const int item = tid + 512 * it, dv = item >> 4, tg = item & 15; vv[it] = *(const u32x4*)(VT + (size_t)(h * 128 + dv) * MTOK + row0 + 8 * tg); }
}
DI void write_vt(LAS unsigned char* Vt, int tid, const u32x4 (&vv)[4]) {
#pragma unroll
    for (int it = 0; it < 4; ++it) { const int item = tid + 512 * it, dv = item >> 4, tg = item & 15; *(LAS u32x4*)(Vt + dv * 272 + tg * 16) = vv[it]; }
}

DI void r1_phase(LAS unsigned char* lds, const bf16_t* Kb, const bf16_t* VT, f32x4* ST, u32x4* BSVL, const float* decf, const float* decb, int G, int bid, int tid) {
    const int lane = tid & 63, w = __builtin_amdgcn_readfirstlane(tid >> 6), r = lane & 15, q = lane >> 4;
    LAS unsigned char* Vt = lds + L_VT; LAS unsigned char* Ktf = lds + L_KT; LAS unsigned char* Ktb = lds + L_KT2;
#pragma unroll 1
    for (int u = bid; u < NUNIT_R; u += G) {
        const int seg = u >> 3, h = u & 7;
        const float lf2 = log2_gamma(decf[h]), lb2 = log2_gamma(decb[h]);
        f32x4 accF[4], accB[4];
#pragma unroll
        for (int dt = 0; dt < 4; ++dt) { accF[dt] = (f32x4){0.f, 0.f, 0.f, 0.f}; accB[dt] = (f32x4){0.f, 0.f, 0.f, 0.f}; }
        const float cdb = ex2(128.f * lb2);
        u32x4 ka, kb, vv[4];
        load_k(Kb, seg * 512 + 384, h, w, lane, ka, kb); load_vt(VT, seg * 512 + 384, h, tid, vv);
#pragma unroll 1
        for (int c = 3; c >= 0; --c) {
            const float tl = (float)(c * 128 + 2 * lane), tj = (float)(2 * lane);
            const float zf0 = ex2((511.f - tl) * lf2), zf1 = ex2((510.f - tl) * lf2), zb0 = ex2(tj * lb2), zb1 = ex2((tj + 1.f) * lb2);
            { u32x4 p0, p1; p0.x = pk(accB[0][0], accB[0][1]); p0.y = pk(accB[0][2], accB[0][3]); p0.z = pk(accB[1][0], accB[1][1]); p0.w = pk(accB[1][2], accB[1][3]);
              p1.x = pk(accB[2][0], accB[2][1]); p1.y = pk(accB[2][2], accB[2][3]); p1.z = pk(accB[3][0], accB[3][1]); p1.w = pk(accB[3][2], accB[3][3]);
              BSVL[((size_t)(u * 4 + c) * 2 + 0) * 512 + tid] = p0; BSVL[((size_t)(u * 4 + c) * 2 + 1) * 512 + tid] = p1; }
            __syncthreads();
            write_kt(Ktf, ka, kb, zf0, zf1, w, lane); write_kt(Ktb, ka, kb, zb0, zb1, w, lane); write_vt(Vt, tid, vv);
            __syncthreads();
            if (c > 0) { const int row1 = seg * 512 + (c - 1) * 128; load_k(Kb, row1, h, w, lane, ka, kb); load_vt(VT, row1, h, tid, vv); }
            state_mma(accF, Ktf, Vt, w, r, q);
#pragma unroll
            for (int dt = 0; dt < 4; ++dt) accB[dt] *= cdb;
            state_mma(accB, Ktb, Vt, w, r, q);
        }
#pragma unroll
        for (int dt = 0; dt < 4; ++dt) { ST[((size_t)u * 2 + 0) * 2048 + tid * 4 + dt] = accF[dt]; ST[((size_t)u * 2 + 1) * 2048 + tid * 4 + dt] = accB[dt]; }
    }
}

#define R3_IDS int tid = tid0; asm volatile("" : "+v"(tid)); const int lane = tid & 63, r = lane & 15, q = lane >> 4; (void)r; (void)q; (void)lane;
struct R3Stage { u32x4 kv[2], vv[4], qv[2], bs0, bs1; };
DI void r3_preload(R3Stage& st, const bf16_t* Qb, const bf16_t* Kb, const bf16_t* VT, const u32x4* BSV, int row0, int c, int h, int w, int tid0) {
    R3_IDS
    load_vt(VT, row0, h, tid, st.vv);
#pragma unroll
    for (int it = 0; it < 2; ++it) { const int item = tid + 512 * it, tok = item >> 3, g8 = item & 7; st.qv[it] = *(const u32x4*)(Qb + (size_t)(row0 + tok) * 512 + h * 64 + 8 * g8); st.kv[it] = *(const u32x4*)(Kb + (size_t)(row0 + tok) * 512 + h * 64 + 8 * g8); }
    st.bs0 = BSV[(c * 2 + 0) * 512 + tid]; st.bs1 = BSV[(c * 2 + 1) * 512 + tid];
}
DI void r3_phase(LAS unsigned char* lds, const bf16_t* Qb, const bf16_t* Kb, const bf16_t* VT, bf16_t* G1, const bf16_t* U, const bf16_t* SGP, const f32x4* ST, u32x4* BSV,
                 const float* decf, const float* decb, const float* gn, int G, int bid, int tid0, int do_store) {
    const int w = __builtin_amdgcn_readfirstlane(tid0 >> 6);
    LAS unsigned char* Qs = lds + L_QS; LAS unsigned char* Ks = lds + L_KS; LAS unsigned char* Vt = lds + L_VT; LAS unsigned char* Kt = lds + L_KT;
    LAS unsigned char* Ff = lds + L_FF; LAS unsigned char* Fb = lds + L_FB; LAS unsigned char* Os = lds + L_OS; LAS unsigned char* Us = lds + L_US;
#pragma unroll 1
    for (int u = bid; u < NUNIT_R; u += G) {
        const int seg = u >> 3, h = u & 7;
        const int s_lo = seg < 32 ? 0 : 32 + ((seg - 32) & ~7), s_hi = seg < 32 ? 32 : s_lo + 8;
        const int seqlo = s_lo * 512, seqhi = s_hi * 512;
        const float lf2 = log2_gamma(decf[h]), lb2 = log2_gamma(decb[h]);
        const float cdf = ex2(128.f * lf2), cdb = ex2(128.f * lb2);
        f32x4 accF[4], accB[4];
#pragma unroll
        for (int dt = 0; dt < 4; ++dt) { accF[dt] = (f32x4){0.f, 0.f, 0.f, 0.f}; accB[dt] = (f32x4){0.f, 0.f, 0.f, 0.f}; }
        { R3_IDS
          const int nf = min(seg - s_lo, (int)fminf(83.f / fmaxf(-512.f * lf2, 1e-6f), 64.f) + 1), nb = min(s_hi - 1 - seg, (int)fminf(83.f / fmaxf(-512.f * lb2, 1e-6f), 64.f) + 1);
#pragma unroll 4
          for (int i = 0; i < nf; ++i) { const f32x4* sp = ST + ((size_t)((seg - 1 - i) * 8 + h) * 2 + 0) * 2048 + tid * 4; const float fac = ex2(512.f * lf2 * (float)i);
#pragma unroll
              for (int dt = 0; dt < 4; ++dt) accF[dt] += sp[dt] * fac; }
#pragma unroll 4
          for (int i = 0; i < nb; ++i) { const f32x4* sp = ST + ((size_t)((seg + 1 + i) * 8 + h) * 2 + 1) * 2048 + tid * 4; const float fac = ex2(512.f * lb2 * (float)i);
#pragma unroll
              for (int dt = 0; dt < 4; ++dt) accB[dt] += sp[dt] * fac; } }
        const u32x4* BSVu = BSV + (size_t)u * 4096;
        const int half = 1 << (h >> 1);
        R3Stage st;
        r3_preload(st, Qb, Kb, VT, BSVu, seg * 512, 0, h, w, tid0);
#pragma unroll 1
        for (int c = 0; c < 4; ++c) {
            const int row0 = seg * 512 + c * 128;
            { R3_IDS
              const float facb = ex2(128.f * (float)(3 - c) * lb2);
              __syncthreads();
              write_vt(Vt, tid, st.vv);
#pragma unroll
              for (int it = 0; it < 2; ++it) { const int item = tid + 512 * it, tok = item >> 3, g8 = item & 7; *(LAS u32x4*)(Qs + tok * 144 + 16 * g8) = st.qv[it]; *(LAS u32x4*)(Ks + tok * 144 + 16 * g8) = st.kv[it]; }
#pragma unroll
              for (int dt = 0; dt < 4; ++dt) {
                u32x2 ff; ff.x = pk(accF[dt][0], accF[dt][1]); ff.y = pk(accF[dt][2], accF[dt][3]);
                *(LAS u32x2*)(Ff + (16 * w + r) * 144 + (16 * dt + 4 * q) * 2) = ff;
                const unsigned b0w = dt < 2 ? st.bs0[2 * dt] : st.bs1[2 * dt - 4], b1w = dt < 2 ? st.bs0[2 * dt + 1] : st.bs1[2 * dt - 3];
                u32x2 fb; fb.x = pk(bflo(b0w) + facb * accB[dt][0], bfhi(b0w) + facb * accB[dt][1]); fb.y = pk(bflo(b1w) + facb * accB[dt][2], bfhi(b1w) + facb * accB[dt][3]);
                *(LAS u32x2*)(Fb + (16 * w + r) * 144 + (16 * dt + 4 * q) * 2) = fb; }
              __syncthreads(); }
            u32x4 uv[5], g1v[4], sgv[4];
            { R3_IDS
#pragma unroll
              for (int it = 0; it < 5; ++it) { const int item = tid + 512 * it, rr = item >> 4, cgp = item & 15, grow = row0 - 8 + rr; uv[it] = (u32x4){0u, 0u, 0u, 0u};
                if (item < 2304 && grow >= seqlo && grow < seqhi) uv[it] = __builtin_nontemporal_load((const u32x4*)(U + (size_t)grow * DM + h * 128 + 8 * cgp)); }
#pragma unroll
              for (int it = 0; it < 4; ++it) { const int tok = 4 * (tid >> 4) + it, cgp = tid & 15; const size_t goff = (size_t)(row0 + tok) * DM + h * 128 + 8 * cgp;
                g1v[it] = __builtin_nontemporal_load((const u32x4*)(G1 + goff)); sgv[it] = __builtin_nontemporal_load((const u32x4*)(SGP + goff)); } }
            if (c < 3) { R3_IDS
              const float tj = (float)(2 * lane); const float zf0 = ex2((127.f - tj) * lf2), zf1 = ex2((126.f - tj) * lf2);
              const u32x4 ka = *(const LAS u32x4*)(Ks + (2 * lane) * 144 + 16 * w), kb = *(const LAS u32x4*)(Ks + (2 * lane + 1) * 144 + 16 * w);
              write_kt(Kt, ka, kb, zf0, zf1, w, lane); }
            f32x4 ao[8]; float rs;
            { R3_IDS
              u32x4 qf[2];
#pragma unroll
              for (int s = 0; s < 2; ++s) qf[s] = *(const LAS u32x4*)(Qs + (16 * w + r) * 144 + (32 * s + 8 * q) * 2);
              f32x4 as[8];
#pragma unroll
              for (int jt = 0; jt < 8; ++jt) { as[jt] = (f32x4){0.f, 0.f, 0.f, 0.f};
#pragma unroll
                for (int s = 0; s < 2; ++s) { const bf16x8 kx = *(const LAS bf16x8*)(Ks + (16 * jt + r) * 144 + (32 * s + 8 * q) * 2); as[jt] = mfma16(kx, as_bf(qf[s]), as[jt]); } }
              const int i = 16 * w + r;
              {
                const int base = i - 4 * q;
                float ef = ex2((float)base * lf2), eb = ex2(-(float)base * lb2);
                const float c16f = ex2(-16.f * lf2), c16b = ex2(16.f * lb2), c1f = ex2(-lf2), c1b = ex2(lb2);
                float tf[4], tb[4]; tf[0] = 1.f; tb[0] = 1.f;
#pragma unroll
                for (int jj = 1; jj < 4; ++jj) { tf[jj] = tf[jj - 1] * c1f; tb[jj] = tb[jj - 1] * c1b; }
#pragma unroll
                for (int jt = 0; jt < 8; ++jt) {
#pragma unroll
                    for (int jj = 0; jj < 4; ++jj) { const int d = base - 16 * jt - jj; as[jt][jj] *= (d >= 0) ? ef * tf[jj] : eb * tb[jj]; }
                    ef *= c16f; eb *= c16b; } }
              u32x4 pf[4];
#pragma unroll
              for (int s2 = 0; s2 < 4; ++s2) { pf[s2].x = pk(as[2 * s2][0], as[2 * s2][1]); pf[s2].y = pk(as[2 * s2][2], as[2 * s2][3]); pf[s2].z = pk(as[2 * s2 + 1][0], as[2 * s2 + 1][1]); pf[s2].w = pk(as[2 * s2 + 1][2], as[2 * s2 + 1][3]); }
              const float xf = ex2((float)(i + 1) * lf2), xb = ex2((float)(128 - i) * lb2);
              u32x4 qff[2], qbb[2];
#pragma unroll
              for (int s = 0; s < 2; ++s)
#pragma unroll
                for (int k = 0; k < 4; ++k) { const float lo = bflo(qf[s][k]), hi = bfhi(qf[s][k]); qff[s][k] = pk(lo * xf, hi * xf); qbb[s][k] = pk(lo * xb, hi * xb); }
              __builtin_amdgcn_sched_barrier(0);
#pragma unroll
              for (int t = 0; t < 8; ++t) { ao[t] = (f32x4){0.f, 0.f, 0.f, 0.f};
#pragma unroll
                for (int s2 = 0; s2 < 4; ++s2) { const u32x2 lo = *(const LAS u32x2*)(Vt + (16 * t + r) * 272 + (32 * s2 + 4 * q) * 2), hi = *(const LAS u32x2*)(Vt + (16 * t + r) * 272 + (32 * s2 + 16 + 4 * q) * 2);
                    const u32x4 vx = {lo.x, lo.y, hi.x, hi.y}; ao[t] = mfma16(as_bf(vx), as_bf(pf[s2]), ao[t]); }
#pragma unroll
                for (int s = 0; s < 2; ++s) { const bf16x8 fx = *(const LAS bf16x8*)(Ff + (16 * t + r) * 144 + (32 * s + 8 * q) * 2); ao[t] = mfma16(fx, as_bf(qff[s]), ao[t]);
                    const bf16x8 bx = *(const LAS bf16x8*)(Fb + (16 * t + r) * 144 + (32 * s + 8 * q) * 2); ao[t] = mfma16(bx, as_bf(qbb[s]), ao[t]); }
                if (t & 1) __builtin_amdgcn_sched_barrier(0); }
              if (c < 3) {
                __syncthreads();
#pragma unroll
                for (int dt = 0; dt < 4; ++dt) accF[dt] *= cdf;
                state_mma(accF, Kt, Vt, w, r, q); }
              __builtin_amdgcn_sched_barrier(0);
              float s1 = 0.f;
#pragma unroll
              for (int t = 0; t < 8; ++t) s1 += (ao[t][0] + ao[t][1]) + (ao[t][2] + ao[t][3]);
              s1 += __shfl_xor(s1, 16); s1 += __shfl_xor(s1, 32);
              const float mu = s1 * (1.f / 128.f); float s2v = 0.f;
#pragma unroll
              for (int t = 0; t < 8; ++t) { ao[t] = ao[t] - mu; s2v += (ao[t][0] * ao[t][0] + ao[t][1] * ao[t][1]) + (ao[t][2] * ao[t][2] + ao[t][3] * ao[t][3]); }
              s2v += __shfl_xor(s2v, 16); s2v += __shfl_xor(s2v, 32);
              rs = rsqrtf(s2v * (1.f / 128.f) + 1e-6f); }
            if (c < 3) r3_preload(st, Qb, Kb, VT, BSVu, row0 + 128, c + 1, h, w, tid0);
            __syncthreads();
            { R3_IDS
#pragma unroll
              for (int t = 0; t < 8; ++t) { u32x2 o; o.x = pk(ao[t][0] * rs, ao[t][1] * rs); o.y = pk(ao[t][2] * rs, ao[t][3] * rs); *(LAS u32x2*)(Os + (16 * w + r) * 272 + (16 * t + 4 * q) * 2) = o; }
#pragma unroll
              for (int it = 0; it < 5; ++it) { const int item = tid + 512 * it, rr = item >> 4, cgp = item & 15; if (item < 2304) *(LAS u32x4*)(Us + rr * 272 + cgp * 16) = uv[it]; }
              __syncthreads(); }
            { R3_IDS
              const int cgp = tid & 15, tok0 = 4 * (tid >> 4);
              const f32x4 ga = *(const f32x4*)(gn + h * 128 + 8 * cgp), gb = *(const f32x4*)(gn + h * 128 + 8 * cgp + 4);
              float a8[8];
#pragma unroll
              for (int k = 0; k < 8; ++k) a8[k] = 0.f;
              int lo_c = max(row0 + tok0 - half, seqlo), hi_c = lo_c;
#pragma unroll
              for (int it = 0; it < 4; ++it) {
                const int tok = tok0 + it, grow = row0 + tok;
                const size_t goff = (size_t)grow * DM + h * 128 + 8 * cgp;
                const u32x4 g1 = g1v[it], sg = sgv[it];
                const u32x4 on = *(const LAS u32x4*)(Os + tok * 272 + cgp * 16);
                const int lo = max(grow - half, seqlo), hi = min(grow + half, seqhi);
#pragma unroll 1
                for (; hi_c < hi; ++hi_c) { const u32x4 uw = *(const LAS u32x4*)(Us + (hi_c - row0 + 8) * 272 + cgp * 16);
#pragma unroll
                    for (int k = 0; k < 4; ++k) { a8[2 * k] += bflo(uw[k]); a8[2 * k + 1] += bfhi(uw[k]); } }
#pragma unroll 1
                for (; lo_c < lo; ++lo_c) { const u32x4 uw = *(const LAS u32x4*)(Us + (lo_c - row0 + 8) * 272 + cgp * 16);
#pragma unroll
                    for (int k = 0; k < 4; ++k) { a8[2 * k] -= bflo(uw[k]); a8[2 * k + 1] -= bfhi(uw[k]); } }
                const u32x4 own = *(const LAS u32x4*)(Us + (tok + 8) * 272 + cgp * 16);
                const float inv = 1.f / (float)(hi - lo);
                float mo[8];
#pragma unroll
                for (int k = 0; k < 4; ++k) {
                    const float gl = k < 2 ? ga[2 * k] : gb[2 * k - 4], gh = k < 2 ? ga[2 * k + 1] : gb[2 * k - 3];
                    mo[2 * k] = bflo(g1[k]) * bflo(on[k]) * gl + bflo(sg[k]) * (a8[2 * k] * inv - bflo(own[k]));
                    mo[2 * k + 1] = bfhi(g1[k]) * bfhi(on[k]) * gh + bfhi(sg[k]) * (a8[2 * k + 1] * inv - bfhi(own[k])); }
                u32x4 o; o.x = pk(mo[0], mo[1]); o.y = pk(mo[2], mo[3]); o.z = pk(mo[4], mo[5]); o.w = pk(mo[6], mo[7]);
                if (do_store) *(u32x4*)(G1 + goff) = o;
              } }
        }
    }
}


DI void phase_skew(int bid, unsigned span_ticks) {
    const unsigned d = (unsigned)((bid >> 3) & 31) * span_ticks / 32u;
    const unsigned long long t0 = __builtin_amdgcn_s_memrealtime();
    while ((unsigned)(__builtin_amdgcn_s_memrealtime() - t0) < d) __builtin_amdgcn_s_sleep(16);
}

#define XB_TMO      128
#define XB_XCNT(j)  (256  + 64 * (j))
#define XB_XSUB(j)  (1280 + 64 * (j))
#define XB_XGEN(j)  (2304 + 64 * (j))
#define XB_TOP      3328
#define XB_TOPGEN   3392
#define XCD_BAR_WORDS 3456
#define XB_SPIN_CAP (1u << 18)

__device__ __forceinline__ unsigned xb_ld(unsigned* p)              { return __hip_atomic_load(p, __ATOMIC_RELAXED, __HIP_MEMORY_SCOPE_AGENT); }
__device__ __forceinline__ unsigned xb_add(unsigned* p, unsigned v) { return __hip_atomic_fetch_add(p, v, __ATOMIC_RELAXED, __HIP_MEMORY_SCOPE_AGENT); }
__device__ __forceinline__ unsigned xb_xcc_id() { return (unsigned)__builtin_amdgcn_s_getreg((3 << 11) | 20) & 0xFu; }
#define XB_SPIN(cond, bar) do { unsigned _sp = 0; while (cond) { __builtin_amdgcn_s_sleep(1); \
    if ((++_sp & 255u) == 0u) { if (xb_ld(&(bar)[XB_TMO])) break; if (_sp > XB_SPIN_CAP) { atomicAdd(&(bar)[XB_TMO], 1u); break; } } } } while (0)

struct XcdBarrier {
    unsigned* bar; unsigned x;
    volatile LAS unsigned* st;
};

__device__ __forceinline__ XcdBarrier xcd_barrier_post(unsigned* bar, volatile LAS unsigned* st) {
    XcdBarrier b; b.bar = bar; b.x = xb_xcc_id(); b.st = st;
    if (threadIdx.x == 0) (void)xb_add(&bar[XB_XCNT(b.x)], 1u);
    return b;
}
__device__ __forceinline__ void xcd_barrier_complete(unsigned* bar, unsigned x, unsigned& nloc, unsigned& nx) {
    const unsigned G = gridDim.x * gridDim.y * gridDim.z;
    unsigned sum, cnt, mine, sp = 0u;
    for (;;) {
        sum = 0u; cnt = 0u; mine = 0u;
#pragma unroll
        for (unsigned j = 0; j < 16; ++j) { const unsigned c = xb_ld(&bar[XB_XCNT(j)]); sum += c; cnt += (c > 0u) ? 1u : 0u; mine = (j == x) ? c : mine; }
        if (sum == G) break;
        __builtin_amdgcn_s_sleep(1);
        if ((++sp & 255u) == 0u) { if (xb_ld(&bar[XB_TMO])) break; if (sp > XB_SPIN_CAP) { atomicAdd(&bar[XB_TMO], 1u); break; } }
    }
    nloc = mine > 0u ? mine : 1u; nx = cnt > 0u ? cnt : 1u;
}

__device__ __forceinline__ void xcd_barrier(const XcdBarrier& b) {
    asm volatile("s_waitcnt vmcnt(0)" ::: "memory");
    __syncthreads();
    if (threadIdx.x == 0) {
        unsigned* bar = b.bar;
        __builtin_amdgcn_s_waitcnt(0);
        unsigned nloc = b.st[0], nx = b.st[1];
        if (nloc == 0u) { xcd_barrier_complete(bar, b.x, nloc, nx); b.st[0] = nloc; b.st[1] = nx; }
        const unsigned old = xb_add(&bar[XB_XSUB(b.x)], 1u);
        const unsigned gen = old / nloc;
        if (old + 1u == (gen + 1u) * nloc) {
            __builtin_amdgcn_fence(__ATOMIC_RELEASE, "agent");
            asm volatile("s_waitcnt vmcnt(0)" ::: "memory");
            const unsigned og = xb_add(&bar[XB_TOP], 1u);
            const unsigned tg = og / nx;
            if (og + 1u == (tg + 1u) * nx) xb_add(&bar[XB_TOPGEN], 1u);
            else XB_SPIN(xb_ld(&bar[XB_TOPGEN]) == tg, bar);
            __builtin_amdgcn_fence(__ATOMIC_ACQUIRE, "agent");
            xb_add(&bar[XB_XGEN(b.x)], 1u);
            asm volatile("s_waitcnt vmcnt(0)" ::: "memory");
        } else {
            XB_SPIN(xb_ld(&bar[XB_XGEN(b.x)]) == gen, bar);
            __builtin_amdgcn_fence(__ATOMIC_ACQUIRE, "agent");
            asm volatile("s_waitcnt vmcnt(0)" ::: "memory");
        }
    }
    __syncthreads();
}

__global__ void __launch_bounds__(512, 2) fwd_megakernel(Params p) {
    extern __shared__ __attribute__((aligned(16))) unsigned char lds_raw[];
    LAS unsigned char* lds = (LAS unsigned char*)lds_raw;
    cg::grid_group grid = cg::this_grid();
    volatile LAS unsigned* bst = (volatile LAS unsigned*)(lds + 139264);
    if (threadIdx.x < 2) bst[threadIdx.x] = 0u;
    __syncthreads();
    (void)xcd_barrier_post((unsigned*)(arg_ws() + WS_BAR), bst);
#define GRID_BAR() do { XcdBarrier b_; b_.bar = (unsigned*)(arg_ws() + WS_BAR); b_.x = xb_xcc_id(); b_.st = bst; xcd_barrier(b_); } while (0)
#define FRESH_IDS int tid = threadIdx.x; asm volatile("" : "+v"(tid)); const int lane = tid & 63, wave = __builtin_amdgcn_readfirstlane(tid >> 6); const int G = gridDim.x, bid = blockIdx.x, gw = bid * 8 + wave, NGW = G * 8; (void)lane; (void)gw; (void)NGW;
#define WSB(T, off) ((T*)(arg_ws() + (off)))

    { FRESH_IDS float* rope = WSB(float, WS_ROPE);
      for (int e = bid * 512 + tid; e < SEQ_P * 32; e += G * 512) {
        const int pos = e >> 5, i = e & 31; double rev = (double)pos * ROPE_INV[i] * 0.15915494309189535; rev -= floor(rev); const float rf = (float)rev;
        rope[pos * 64 + i] = __builtin_amdgcn_cosf(rf); rope[pos * 64 + 32 + i] = __builtin_amdgcn_sinf(rf); } }
#if PH & 1
    { FRESH_IDS convert_layer(0, lds, gw, NGW, wave, lane); }
#endif
    { FRESH_IDS e0_phase(arg_in(0), arg_in(1), WSB(bf16_t, WS_HM), WSB(float, WS_RS), gw, NGW, lane); }
    grid.sync();

#pragma unroll 1
    for (int l = 0; l < DEPTH; ++l) {
#if PH & 2
        _Pragma("unroll 1") for (int rep = 0; rep < GA_REP; ++rep)
        { FRESH_IDS unsigned char* ws = arg_ws();
          pg8::Gemm g{(bf16_t*)(ws + WS_HM), (bf16_t*)(ws + WS_BTIN), MTOK, NWIN, DM}; pg8::StaticOrder S; S.init(MTOK, NWIN, G, bid);
          pg8::EpiWin E{(bf16_t*)(ws + WS_Q), (bf16_t*)(ws + WS_K), (bf16_t*)(ws + WS_G1), (bf16_t*)(ws + WS_U), (bf16_t*)(ws + WS_SGP), (const float*)(ws + WS_ROPE)};
          pg8::gemm_phase<pg8::EpiWin, pg8::StaticOrder, true, true>(lds, g, S, E); }
#endif
#if PH & 4
        _Pragma("unroll 1") for (int rep = 0; rep < GA_REP; ++rep)
        { FRESH_IDS unsigned char* ws = arg_ws();
          pg8::Gemm g{(bf16_t*)(ws + WS_WVT), (bf16_t*)(ws + WS_HM), DM, MTOK, DM}; pg8::StaticOrder S; S.init(DM, MTOK, G, bid);
          pg8::EpiBf<0> E{(bf16_t*)(ws + WS_VT), (size_t)MTOK};
          pg8::gemm_phase<pg8::EpiBf<0>, pg8::StaticOrder, true, true>(lds, g, S, E); }
#endif
        _Pragma("unroll 1") for (int rep = 0; rep < SYNC_REP; ++rep) GRID_BAR();
#if PH & 8
        _Pragma("unroll 1") for (int rep = 0; rep < R1_REP; ++rep)
        { FRESH_IDS unsigned char* ws = arg_ws();
          r1_phase(lds, (const bf16_t*)(ws + WS_K), (const bf16_t*)(ws + WS_VT), (f32x4*)arg_out(), (u32x4*)((unsigned char*)arg_out() + 96 * MiB), arg_in(5) + l * 8, arg_in(6) + l * 8, G, bid, tid); }
#endif
        _Pragma("unroll 1") for (int rep = 0; rep < SYNC_REP; ++rep) GRID_BAR();
#if PH & 16
        _Pragma("unroll 1") for (int rep = 0; rep < R3_REP; ++rep)
        { FRESH_IDS unsigned char* ws = arg_ws(); int ds = (rep == R3_REP - 1); asm volatile("" : "+s"(ds));
          r3_phase(lds, (const bf16_t*)(ws + WS_Q), (const bf16_t*)(ws + WS_K), (const bf16_t*)(ws + WS_VT), (bf16_t*)(ws + WS_G1), (const bf16_t*)(ws + WS_U), (const bf16_t*)(ws + WS_SGP),
                   (const f32x4*)arg_out(), (u32x4*)((unsigned char*)arg_out() + 96 * MiB), arg_in(5) + l * 8, arg_in(6) + l * 8, arg_in(7) + l * DM, G, bid, tid, ds); }
#endif
        _Pragma("unroll 1") for (int rep = 0; rep < SYNC_REP; ++rep) GRID_BAR();
#if PH & 32
        _Pragma("unroll 1") for (int rep = 0; rep < GD_REP; ++rep)
        { FRESH_IDS unsigned char* ws = arg_ws();
          pg8::Gemm g{(bf16_t*)(ws + WS_G1), (bf16_t*)(ws + WS_BTO), MTOK, DM, DM}; pg8::StaticOrder S; S.init(MTOK, DM, G, bid);
          pg8::EpiBf<0> E{(bf16_t*)(ws + WS_Y), (size_t)DM};
          pg8::gemm_phase<pg8::EpiBf<0>, pg8::StaticOrder, true, true>(lds, g, S, E); }
#endif
        _Pragma("unroll 1") for (int rep = 0; rep < SYNC_REP; ++rep) GRID_BAR();
        _Pragma("unroll 1") for (int rep = 0; rep < E_REP; ++rep)
        { FRESH_IDS float* out = arg_out(); int ds = (rep == E_REP - 1); asm volatile("" : "+s"(ds));
          (void)out; e_phase(WSB(bf16_t, WS_Y), WSB(bf16_t, WS_HM), WSB(float, WS_RS), arg_in(3) + l * DM, nullptr, gw, NGW, lane, ds); }
        _Pragma("unroll 1") for (int rep = 0; rep < SYNC_REP; ++rep) GRID_BAR();
#if PH & 64
        _Pragma("unroll 1") for (int rep = 0; rep < GF_REP; ++rep)
        { FRESH_IDS unsigned char* ws = arg_ws();
          pg8::Gemm g{(bf16_t*)(ws + WS_HM), (bf16_t*)(ws + WS_BT1), MTOK, DFF, DM}; pg8::StaticOrder S; S.init(MTOK, DFF, G, bid);
          pg8::EpiBf<1> E{(bf16_t*)(ws + WS_F), (size_t)DFF};
          pg8::gemm_phase<pg8::EpiBf<1>, pg8::StaticOrder, true, true>(lds, g, S, E); }
#endif
        _Pragma("unroll 1") for (int rep = 0; rep < SYNC_REP; ++rep) GRID_BAR();
#if PH & 128
        _Pragma("unroll 1") for (int rep = 0; rep < GG_REP; ++rep)
        { FRESH_IDS unsigned char* ws = arg_ws();
          pg8::Gemm g{(bf16_t*)(ws + WS_F), (bf16_t*)(ws + WS_BT2), MTOK, DM, DFF}; pg8::StaticOrder S; S.init(MTOK, DM, G, bid);
          pg8::EpiBf<0> E{(bf16_t*)(ws + WS_Y), (size_t)DM};
          pg8::gemm_phase<pg8::EpiBf<0>, pg8::StaticOrder, true, true>(lds, g, S, E); }
#endif
        _Pragma("unroll 1") for (int rep = 0; rep < SYNC_REP; ++rep) GRID_BAR();
        _Pragma("unroll 1") for (int rep = 0; rep < E_REP; ++rep)
        { FRESH_IDS float* out = arg_out(); int ds = (rep == E_REP - 1); asm volatile("" : "+s"(ds));
          e_phase(WSB(bf16_t, WS_Y), WSB(bf16_t, WS_HM), WSB(float, WS_RS), arg_in(12) + l * DM, l + 1 < DEPTH ? nullptr : out, gw, NGW, lane, ds); }
        if (l + 1 < DEPTH) {
#if PH & 1
            _Pragma("unroll 1") for (int rep = 0; rep < CV_REP; ++rep) { FRESH_IDS convert_layer(l + 1, lds, gw, NGW, wave, lane); }
#endif
            GRID_BAR(); }
    }
}

extern "C" void kernel_launch(void* const* d_in, const int* in_sizes, int n_in, void* d_out, int out_size, void* d_ws, size_t ws_size, hipStream_t stream) {
    static int grid = 0;
    if (grid == 0) {
        if (n_in != 15 || out_size != MTOK * DM || ws_size < WS_END) { fprintf(stderr, "kernel_launch: unexpected shapes (n_in %d, out %d, ws %zu)\n", n_in, out_size, ws_size); grid = -1; return; }
        int dev = 0, cus = 0, per_cu = 0;
        hipGetDevice(&dev); hipDeviceGetAttribute(&cus, hipDeviceAttributeMultiprocessorCount, dev);
        if (hipFuncSetAttribute((const void*)fwd_megakernel, hipFuncAttributeMaxDynamicSharedMemorySize, LDS_BYTES) != hipSuccess) { fprintf(stderr, "kernel_launch: hipFuncSetAttribute failed\n"); grid = -1; return; }
        if (hipOccupancyMaxActiveBlocksPerMultiprocessor(&per_cu, (const void*)fwd_megakernel, 512, LDS_BYTES) != hipSuccess || per_cu < 1) { fprintf(stderr, "kernel_launch: occupancy query failed (%d)\n", per_cu); (void)hipGetLastError(); per_cu = 1; }
        grid = cus * per_cu;
    }
    if (grid < 0) return;
    if (hipMemsetAsync(d_ws, 0, 131072, stream) != hipSuccess) { fprintf(stderr, "kernel_launch: memset of the barrier words failed\n"); return; }
    Params p{};
    for (int i = 0; i < 15; ++i) p.in[i] = (const float*)d_in[i];
    p.out = (float*)d_out; p.ws = (unsigned char*)d_ws;
    void* args[] = {&p};
    hipError_t e = hipLaunchCooperativeKernel((const void*)fwd_megakernel, dim3(grid), dim3(512), args, LDS_BYTES, stream);
    if (e != hipSuccess) fprintf(stderr, "kernel_launch: cooperative launch failed: %s (grid %d)\n", hipGetErrorString(e), grid);
}
```
